# Optimizing an MI355X kernel written in HIP

```python
import math
import jax, jax.numpy as jnp
from jax import lax

D_MODEL = 1024
BATCH = 2
SEQ = 8192
DEPTH = 2
DEC_BATCH = 128
DEC_SEQ = 1
PAST_LEN = 8192
PAGE_SIZE = 128

F32 = jnp.float32
EPS = 1e-6
N_META = 16
CHUNK = 64
A_HEADS = 8
A_KV_HEADS = 2
A_HEAD_DIM = 64
A_GROUP = A_HEADS // A_KV_HEADS
A_WIDTH = A_HEADS * A_HEAD_DIM
A_KV_WIDTH = A_KV_HEADS * A_HEAD_DIM
WINDOW = 128
A_BLOCK = 128
B_HEADS = 4
B_DK = 128
B_DV = 128
B_KEY = B_HEADS * B_DK
B_VAL = B_HEADS * B_DV
CONV_W = 4
B_CONV_CH = 2 * B_KEY + B_VAL
C_HEADS = 4
C_KEY = D_MODEL // 2
C_VAL = D_MODEL
C_DK = C_KEY // C_HEADS
C_DV = C_VAL // C_HEADS
C_GATE_RANK = 16
C_GATE_NORM = 16.0
N_AB_LAYERS = (DEPTH + 1) // 2
N_C_LAYERS = DEPTH // 2
WIN_BUF = min(WINDOW, PAST_LEN)
LEAD_PROMPT = (-N_META) % CHUNK
AB_SIZES = (A_WIDTH, A_KV_WIDTH, A_KV_WIDTH, A_WIDTH, B_CONV_CH, B_VAL, B_HEADS, B_HEADS)
AB_IN = A_WIDTH + 2 * A_KV_WIDTH + A_WIDTH + B_CONV_CH + B_VAL + 2 * B_HEADS
AB_MIX = A_WIDTH + B_VAL
C_SIZES = (C_KEY, C_KEY, C_VAL, C_VAL, C_GATE_RANK)
C_IN = 2 * C_KEY + 2 * C_VAL + C_GATE_RANK

kernel_name = 'hybrid_swa_sink_gdn_gla_meta_step'


def _rmsnorm(x, g):
    xf = x.astype(F32)
    y = xf * lax.rsqrt(jnp.mean(xf * xf, axis=-1, keepdims=True) + EPS)
    return (y * g.astype(F32)).astype(x.dtype)


def _l2norm(x):
    xf = x.astype(F32)
    return xf * lax.rsqrt(jnp.sum(xf * xf, axis=-1, keepdims=True) + EPS)


def _split(h, sizes):
    out, s = [], 0
    for n in sizes:
        out.append(h[..., s:s + n])
        s += n
    return out


def _sink_attend(q, k, v, mask, sink):
    s = jnp.einsum('...qhgd,...khd->...hgqk', q.astype(F32), k.astype(F32)) * (A_HEAD_DIM ** -0.5)
    s = jnp.where(mask[..., None, None, :, :], s, -jnp.inf)
    sk = sink.astype(F32)[:, :, None, None]
    m = jnp.maximum(jnp.max(s, axis=-1, keepdims=True), sk)
    p = jnp.exp(s - m)
    p = p / (jnp.sum(p, axis=-1, keepdims=True) + jnp.exp(sk - m))
    o = jnp.einsum('...hgqk,...khd->...qhgd', p, v.astype(F32))
    return o.astype(q.dtype)


def _swa_prompt(q, k, v, sink):
    Bn, L = q.shape[:2]
    nb = -(-L // A_BLOCK)
    Lp = nb * A_BLOCK
    qb = jnp.pad(q, ((0, 0), (0, Lp - L), (0, 0), (0, 0))).reshape(Bn, nb, A_BLOCK, A_KV_HEADS, A_GROUP, A_HEAD_DIM)
    kvpad = ((0, 0), (A_BLOCK, Lp - L), (0, 0), (0, 0))
    kb = jnp.pad(k, kvpad).reshape(Bn, nb + 1, A_BLOCK, A_KV_HEADS, A_HEAD_DIM)
    vb = jnp.pad(v, kvpad).reshape(Bn, nb + 1, A_BLOCK, A_KV_HEADS, A_HEAD_DIM)
    kband = jnp.concatenate([kb[:, :-1], kb[:, 1:]], axis=2)
    vband = jnp.concatenate([vb[:, :-1], vb[:, 1:]], axis=2)
    blk = jnp.arange(nb)[:, None] * A_BLOCK
    qpos = blk + jnp.arange(A_BLOCK)[None, :]
    kpos = blk - A_BLOCK + jnp.arange(2 * A_BLOCK)[None, :]
    diff = qpos[:, :, None] - kpos[:, None, :]
    mask = (diff >= 0) & (diff < WINDOW) & (kpos[:, None, :] >= 0)
    o = _sink_attend(qb, kband, vband, mask, sink)
    return o.reshape(Bn, Lp, A_HEADS, A_HEAD_DIM)[:, :L]


def _swa_sample(q, k_new, v_new, k_buf, v_buf, sink):
    Bn, T = q.shape[:2]
    nbuf = k_buf.shape[1]
    k = jnp.concatenate([k_buf.astype(k_new.dtype), k_new], axis=1)
    v = jnp.concatenate([v_buf.astype(v_new.dtype), v_new], axis=1)
    qpos = PAST_LEN + jnp.arange(T)
    kpos = PAST_LEN - nbuf + jnp.arange(nbuf + T)
    diff = qpos[:, None] - kpos[None, :]
    mask = (diff >= 0) & (diff < WINDOW)
    o = _sink_attend(q.reshape(Bn, T, A_KV_HEADS, A_GROUP, A_HEAD_DIM), k, v, mask, sink)
    return o.reshape(Bn, T, A_HEADS, A_HEAD_DIM), k[:, T:], v[:, T:]


def _causal_conv_silu(xc, w):
    T = xc.shape[1] - (CONV_W - 1)
    y = xc[:, 0:T] * w[0]
    for i in range(1, CONV_W):
        y = y + xc[:, i:i + T] * w[i]
    return jax.nn.silu(y)


def _to_chunks(a, lead, tail):
    a = jnp.pad(a.astype(F32), ((0, 0), (lead, tail)) + ((0, 0),) * (a.ndim - 2))
    Bn, Tp = a.shape[:2]
    a = a.reshape((Bn, Tp // CHUNK, CHUNK) + a.shape[2:])
    return jnp.moveaxis(a, 2, 3)


def _from_chunks(o, lead, T):
    o = jnp.moveaxis(jnp.moveaxis(o, 0, 1), 2, 3)
    Bn, N, C, H, d = o.shape
    return o.reshape(Bn, N * C, H, d)[:, lead:lead + T]


def _gated_delta_chunked(q, k, v, beta, g, s0, lead):
    T = q.shape[1]
    tail = (-(T + lead)) % CHUNK
    qc, kc, vc = (_to_chunks(a, lead, tail) for a in (q, k, v))
    bc, gcs = (_to_chunks(a, lead, tail) for a in (beta, g))
    gc = jnp.cumsum(gcs, axis=-1)
    idx = jnp.arange(CHUNK)
    lower = idx[:, None] >= idx[None, :]
    strict = idx[:, None] > idx[None, :]
    decay = jnp.exp(jnp.where(lower, gc[..., :, None] - gc[..., None, :], -jnp.inf))
    kbeta = kc * bc[..., None]
    a_mat = jnp.where(strict, jnp.einsum('bnhik,bnhjk->bnhij', kbeta, kc) * decay, 0.0) + jnp.eye(CHUNK, dtype=F32)
    rhs = jnp.concatenate([vc * bc[..., None], kbeta * jnp.exp(gc)[..., None]], axis=-1)
    sol = lax.linalg.triangular_solve(a_mat, rhs, left_side=True, lower=True, unit_diagonal=True)
    u, w = sol[..., :B_DV], sol[..., B_DV:]
    qk = jnp.where(lower, jnp.einsum('bnhik,bnhjk->bnhij', qc, kc) * decay, 0.0)
    q_dec = qc * jnp.exp(gc)[..., None]
    k_dec = kc * jnp.exp(gc[..., -1:] - gc)[..., None]
    g_last = jnp.exp(gc[..., -1])

    def step(S, xs):
        u_c, w_c, qk_c, qd_c, kd_c, gl_c = xs
        v_new = u_c - jnp.einsum('bhck,bhkv->bhcv', w_c, S)
        o = jnp.einsum('bhck,bhkv->bhcv', qd_c, S) + jnp.einsum('bhij,bhjv->bhiv', qk_c, v_new)
        S = S * gl_c[..., None, None] + jnp.einsum('bhck,bhcv->bhkv', kd_c, v_new)
        return S, o

    xs = tuple(jnp.moveaxis(a, 1, 0) for a in (u, w, qk, q_dec, k_dec, g_last))
    S, o = lax.scan(step, s0.astype(F32), xs)
    return _from_chunks(o, lead, T), S


def _gla_chunked(q, k, v, log_a, s0, lead):
    T = q.shape[1]
    tail = (-(T + lead)) % CHUNK
    qc, kc, vc, lc = (_to_chunks(a, lead, tail) for a in (q, k, v, log_a))
    bc = jnp.cumsum(lc, axis=-2)
    idx = jnp.arange(CHUNK)
    lower = idx[:, None] >= idx[None, :]
    q_dec = qc * jnp.exp(bc)
    qk = jnp.einsum('bnhik,bnhjk->bnhij', q_dec, kc * jnp.exp(-bc))
    o_intra = jnp.einsum('bnhij,bnhjv->bnhiv', jnp.where(lower, qk, 0.0), vc)
    k_dec = kc * jnp.exp(bc[..., -1:, :] - bc)
    g_last = jnp.exp(bc[..., -1, :])

    def step(S, xs):
        qd_c, kd_c, v_c, gl_c, oi_c = xs
        o = oi_c + jnp.einsum('bhck,bhkv->bhcv', qd_c, S)
        S = S * gl_c[..., None] + jnp.einsum('bhck,bhcv->bhkv', kd_c, v_c)
        return S, o

    xs = tuple(jnp.moveaxis(a, 1, 0) for a in (q_dec, k_dec, vc, g_last, o_intra))
    S, o = lax.scan(step, s0.astype(F32), xs)
    return _from_chunks(o, lead, T), S


def _ab_layer(x, norm_g, w_in, sink, conv_w, a_log, dt_bias, onorm, w_out, k_buf, v_buf, conv_buf, s0, lead):
    Bn, T, _ = x.shape
    h = _rmsnorm(x, norm_g)
    proj = jnp.einsum('btd,de->bte', h, w_in)
    qa, ka, va, za, xb, zb, bb, ab = _split(proj, AB_SIZES)
    qa = qa.reshape(Bn, T, A_HEADS, A_HEAD_DIM)
    ka = ka.reshape(Bn, T, A_KV_HEADS, A_HEAD_DIM)
    va = va.reshape(Bn, T, A_KV_HEADS, A_HEAD_DIM)
    sink = sink.reshape(A_KV_HEADS, A_GROUP)
    if k_buf is None:
        oa = _swa_prompt(qa, ka, va, sink)
        n_keep = min(WINDOW, T)
        new_k, new_v = ka[:, T - n_keep:], va[:, T - n_keep:]
        conv_buf = jnp.zeros((Bn, CONV_W - 1, B_CONV_CH), xb.dtype)
        s0 = jnp.zeros((Bn, B_HEADS, B_DK, B_DV), F32)
    else:
        oa, new_k, new_v = _swa_sample(qa, ka, va, k_buf, v_buf, sink)
    xc = jnp.concatenate([conv_buf.astype(xb.dtype), xb], axis=1)
    new_conv = xc[:, xc.shape[1] - (CONV_W - 1):]
    c = _causal_conv_silu(xc, conv_w.astype(xb.dtype))
    qb, kb, vb = _split(c, (B_KEY, B_KEY, B_VAL))
    qb = _l2norm(qb.reshape(Bn, T, B_HEADS, B_DK)) * (B_DK ** -0.5)
    kb = _l2norm(kb.reshape(Bn, T, B_HEADS, B_DK))
    vb = vb.reshape(Bn, T, B_HEADS, B_DV)
    beta = jax.nn.sigmoid(bb.astype(F32))
    g = -jnp.exp(a_log.astype(F32)) * jax.nn.softplus(ab.astype(F32) + dt_bias.astype(F32))
    ob, s_new = _gated_delta_chunked(qb, kb, vb, beta, g, s0, lead)
    ob = _rmsnorm(ob.astype(x.dtype), onorm) * jax.nn.silu(zb.reshape(Bn, T, B_HEADS, B_DV))
    oa = oa.reshape(Bn, T, A_WIDTH) * jax.nn.silu(za)
    mix = jnp.concatenate([oa, ob.reshape(Bn, T, B_VAL)], axis=-1)
    y = x + jnp.einsum('bte,ed->btd', mix, w_out)
    return y, (new_k, new_v, new_conv, s_new.astype(x.dtype))


def _c_layer(x, norm_g, w_in, w_gk_up, b_gk, onorm, w_out, s0, lead):
    Bn, T, _ = x.shape
    h = _rmsnorm(x, norm_g)
    proj = jnp.einsum('btd,de->bte', h, w_in)
    qc, kc, vc, zc, gk_low = _split(proj, C_SIZES)
    log_a = jax.nn.log_sigmoid(jnp.einsum('btr,rk->btk', gk_low.astype(F32), w_gk_up.astype(F32)) + b_gk.astype(F32)) / C_GATE_NORM
    q = qc.reshape(Bn, T, C_HEADS, C_DK) * (C_DK ** -0.5)
    k = kc.reshape(Bn, T, C_HEADS, C_DK)
    v = vc.reshape(Bn, T, C_HEADS, C_DV)
    if s0 is None:
        s0 = jnp.zeros((Bn, C_HEADS, C_DK, C_DV), F32)
    o, s_new = _gla_chunked(q, k, v, log_a.reshape(Bn, T, C_HEADS, C_DK), s0, lead)
    o = _rmsnorm(o.astype(x.dtype), onorm) * jax.nn.silu(zc.reshape(Bn, T, C_HEADS, C_DV))
    y = x + jnp.einsum('bte,ed->btd', o.reshape(Bn, T, C_VAL), w_out)
    return y, s_new.astype(x.dtype)


def setup_inputs(seed: int = 0) -> dict:
    key = jax.random.key(seed)
    ks = jax.random.split(key, 24)

    def nrm(k, shape, scale):
        return jax.random.normal(k, shape, F32) * scale

    dt = jnp.exp(jax.random.uniform(ks[13], (N_AB_LAYERS, B_HEADS), F32, math.log(1e-3), math.log(1e-1)))
    return {
        'x_prompt': nrm(ks[0], (BATCH, SEQ, D_MODEL), 1.0),
        'x_sample': nrm(ks[1], (DEC_BATCH, DEC_SEQ, D_MODEL), 1.0),
        'cache_swa_k': nrm(ks[2], (N_AB_LAYERS, DEC_BATCH, WIN_BUF, A_KV_HEADS, A_HEAD_DIM), 1.0),
        'cache_swa_v': nrm(ks[3], (N_AB_LAYERS, DEC_BATCH, WIN_BUF, A_KV_HEADS, A_HEAD_DIM), 1.0),
        'state_dn_conv': nrm(ks[4], (N_AB_LAYERS, DEC_BATCH, CONV_W - 1, B_CONV_CH), 1.0),
        'state_dn': nrm(ks[5], (N_AB_LAYERS, DEC_BATCH, B_HEADS, B_DK, B_DV), 0.1),
        'state_gla': nrm(ks[6], (N_C_LAYERS, DEC_BATCH, C_HEADS, C_DK, C_DV), 1.0),
        'meta_tokens': nrm(ks[7], (N_META, D_MODEL), 1.0),
        'norm_ab': 1.0 + nrm(ks[8], (N_AB_LAYERS, D_MODEL), 0.05),
        'w_in_ab': nrm(ks[9], (N_AB_LAYERS, D_MODEL, AB_IN), D_MODEL ** -0.5),
        'sink_a': nrm(ks[10], (N_AB_LAYERS, A_HEADS), 0.5),
        'conv_b': nrm(ks[11], (N_AB_LAYERS, CONV_W, B_CONV_CH), CONV_W ** -0.5),
        'a_log_b': jnp.log(jax.random.uniform(ks[12], (N_AB_LAYERS, B_HEADS), F32, 1.0, 16.0)),
        'dt_bias_b': dt + jnp.log(-jnp.expm1(-dt)),
        'onorm_b': 1.0 + nrm(ks[14], (N_AB_LAYERS, B_DV), 0.05),
        'w_out_ab': nrm(ks[15], (N_AB_LAYERS, AB_MIX, D_MODEL), AB_MIX ** -0.5),
        'norm_c': 1.0 + nrm(ks[16], (N_C_LAYERS, D_MODEL), 0.05),
        'w_in_c': nrm(ks[17], (N_C_LAYERS, D_MODEL, C_IN), D_MODEL ** -0.5),
        'w_gk_up': nrm(ks[18], (N_C_LAYERS, C_GATE_RANK, C_KEY), C_GATE_RANK ** -0.5),
        'b_gk': nrm(ks[19], (N_C_LAYERS, C_KEY), 0.1),
        'onorm_c': 1.0 + nrm(ks[20], (N_C_LAYERS, C_DV), 0.05),
        'w_out_c': nrm(ks[21], (N_C_LAYERS, C_VAL, D_MODEL), C_VAL ** -0.5),
        'final_norm': 1.0 + nrm(ks[22], (D_MODEL,), 0.05),
    }


def reference(x_prompt, x_sample, cache_swa_k, cache_swa_v, state_dn_conv, state_dn, state_gla,
              meta_tokens, norm_ab, w_in_ab, sink_a, conv_b, a_log_b, dt_bias_b, onorm_b, w_out_ab,
              norm_c, w_in_c, w_gk_up, b_gk, onorm_c, w_out_c, final_norm):
    Bp = x_prompt.shape[0]
    meta = jnp.broadcast_to(meta_tokens.astype(x_prompt.dtype)[None], (Bp, N_META, D_MODEL))
    hp = jnp.concatenate([meta, x_prompt], axis=1)
    hs = x_sample
    pk, pv, pconv, pdn, pgla = [], [], [], [], []
    sk, sv, sconv, sdn, sgla = [], [], [], [], []
    for layer in range(DEPTH):
        i = layer // 2
        if layer % 2 == 0:
            hp, (k1, v1, c1, d1) = _ab_layer(hp, norm_ab[i], w_in_ab[i], sink_a[i], conv_b[i], a_log_b[i], dt_bias_b[i],
                                            onorm_b[i], w_out_ab[i], None, None, None, None, LEAD_PROMPT)
            hs, (k2, v2, c2, d2) = _ab_layer(hs, norm_ab[i], w_in_ab[i], sink_a[i], conv_b[i], a_log_b[i], dt_bias_b[i],
                                            onorm_b[i], w_out_ab[i], cache_swa_k[i], cache_swa_v[i],
                                            state_dn_conv[i], state_dn[i], 0)
            pk.append(k1); pv.append(v1); pconv.append(c1); pdn.append(d1)
            sk.append(k2); sv.append(v2); sconv.append(c2); sdn.append(d2)
        else:
            hp, g1 = _c_layer(hp, norm_c[i], w_in_c[i], w_gk_up[i], b_gk[i], onorm_c[i], w_out_c[i], None, LEAD_PROMPT)
            hs, g2 = _c_layer(hs, norm_c[i], w_in_c[i], w_gk_up[i], b_gk[i], onorm_c[i], w_out_c[i], state_gla[i], 0)
            pgla.append(g1)
            sgla.append(g2)
    y_prompt = _rmsnorm(hp, final_norm)[:, N_META:]
    y_sample = _rmsnorm(hs, final_norm)
    return (y_prompt, y_sample,
            jnp.stack(pk), jnp.stack(pv), jnp.stack(pconv), jnp.stack(pdn), jnp.stack(pgla),
            jnp.stack(sk), jnp.stack(sv), jnp.stack(sconv), jnp.stack(sdn), jnp.stack(sgla))
```

```cpp
#include <hip/hip_runtime.h>
#include <hip/hip_cooperative_groups.h>
#include <cstdio>
#include <utility>
namespace cg = cooperative_groups;

typedef unsigned short bf16_t;
typedef __attribute__((ext_vector_type(8))) short bf16x8;
typedef __attribute__((ext_vector_type(4))) short s16x4;
typedef __attribute__((ext_vector_type(16))) float f32x16;
typedef __attribute__((ext_vector_type(4))) unsigned u32x4;
typedef __attribute__((ext_vector_type(4))) float f32x4;
__device__ __forceinline__ float4 nt_load4(const float* p) { const f32x4 v = __builtin_nontemporal_load((const f32x4*)p); return make_float4(v[0], v[1], v[2], v[3]); }
__device__ __forceinline__ void nt_store4(float* p, const float4& a) { f32x4 v; v[0] = a.x; v[1] = a.y; v[2] = a.z; v[3] = a.w; __builtin_nontemporal_store(v, (f32x4*)p); }

#define DI __device__ __forceinline__
#define MFMA32(a, b, c) __builtin_amdgcn_mfma_f32_32x32x16_bf16((a), (b), (c), 0, 0, 0)

constexpr int D = 1024;
constexpr int TP = 8208;
constexpr int NPR = 2 * TP;
constexpr int NROWS = NPR + 128;
constexpr int MP = 16640;
constexpr int NA = 3328;
constexpr int NC = 3072;
constexpr int LDA_IN = 3336;
constexpr int LDC_IN = 3088;
constexpr int LDT = MP + 128;
constexpr int NCH = 129;
constexpr int NCI = 8 * NCH;
constexpr float EPS = 1e-6f;

constexpr size_t O_YP = 0;
constexpr size_t O_YS = O_YP + (size_t)2 * 8192 * 1024;
constexpr size_t O_SKP = O_YS + 128 * 1024;
constexpr size_t O_SVP = O_SKP + 2 * 128 * 128;
constexpr size_t O_CVP = O_SVP + 2 * 128 * 128;
constexpr size_t O_DNP = O_CVP + 2 * 3 * 1536;
constexpr size_t O_GLP = O_DNP + 2 * 4 * 128 * 128;
constexpr size_t O_SKS = O_GLP + 2 * 4 * 128 * 256;
constexpr size_t O_SVS = O_SKS + (size_t)128 * 128 * 128;
constexpr size_t O_CVS = O_SVS + (size_t)128 * 128 * 128;
constexpr size_t O_DNS = O_CVS + (size_t)128 * 3 * 1536;
constexpr size_t O_GLS = O_DNS + (size_t)128 * 4 * 128 * 128;

constexpr size_t al256(size_t x) { return (x + 255) & ~(size_t)255; }
constexpr size_t W_WTA = 0;
constexpr size_t W_WOA = W_WTA + (size_t)NA * 1024 * 2;
constexpr size_t W_WTC = W_WOA + (size_t)1024 * 1024 * 2;
constexpr size_t W_WOC = W_WTC + (size_t)NC * 1024 * 2;
constexpr size_t W_SM0 = W_WOC + (size_t)1024 * 1024 * 2;
constexpr size_t W_SM1 = W_SM0 + (size_t)MP * 8 * 4;
constexpr size_t W_YME = W_SM1 + (size_t)MP * 16 * 4;
constexpr size_t W_DGL = W_YME + (size_t)32 * 1024 * 4;
constexpr size_t W_GGL = al256(W_DGL + (size_t)NCI * 4);
constexpr size_t W_BAR = al256(W_GGL + (size_t)NCI * 128 * 4);
constexpr size_t W_P = al256(W_BAR + 3456 * 4);
constexpr size_t W_M = W_P + (size_t)MP * NA * 2;
constexpr size_t W_X = W_M + (size_t)MP * 1024 * 2;
constexpr size_t W_PT = W_X;
constexpr size_t W_C0 = W_X + (size_t)128 * LDT * 2;
constexpr size_t W_C1 = W_X + (size_t)1024 * LDT * 2;
constexpr size_t C0_W = 0;
constexpr size_t C0_UT = C0_W + (size_t)NCI * 8192 * 2;
constexpr size_t C0_QD = C0_UT + (size_t)NCI * 8192 * 2;
constexpr size_t C0_KDT = C0_QD + (size_t)NCI * 8192 * 2;
constexpr size_t C0_QK = C0_KDT + (size_t)NCI * 8192 * 2;
constexpr size_t W_SNG = al256(W_C1 + (size_t)NCI * 40960);
constexpr size_t W_AG = W_SNG + (size_t)8 * 22 * 128 * 256 * 4;
constexpr int DN_NG = 43, GLA_NG = 22;
constexpr size_t C1_QD = 0;
constexpr size_t C1_KDT = C1_QD + (size_t)NCI * 8192 * 2;
constexpr size_t C1_QK = C1_KDT + (size_t)NCI * 8192 * 2;

constexpr int SMEM_BYTES = 74752;
#ifndef DUP
#define DUP -1
#endif
#define REP(k) for (int rep_ = 0; rep_ < (DUP == (k) ? 2 : 1); ++rep_)

struct Params {
  const float* x_prompt; const float* x_sample; const float* cache_k; const float* cache_v;
  const float* st_conv; const float* st_dn; const float* st_gla; const float* meta;
  const float* norm_ab; const float* w_in_ab; const float* sink; const float* conv_b;
  const float* a_log; const float* dt_bias; const float* onorm_b; const float* w_out_ab;
  const float* norm_c; const float* w_in_c; const float* w_gk_up; const float* b_gk;
  const float* onorm_c; const float* w_out_c; const float* final_norm;
  float* out; unsigned char* ws;
  int coop_flag; int pad_;
};

DI bf16_t f2bf(float x) { unsigned u = __float_as_uint(x); u += 0x7fffu + ((u >> 16) & 1u); return (bf16_t)(u >> 16); }
DI float bf2f(bf16_t s) { return __uint_as_float(((unsigned)s) << 16); }
DI s16x4 pack4(float a, float b, float c, float d) { s16x4 v; v[0] = (short)f2bf(a); v[1] = (short)f2bf(b); v[2] = (short)f2bf(c); v[3] = (short)f2bf(d); return v; }
DI int crow(int reg, int h) { return (reg & 3) + 8 * (reg >> 2) + 4 * h; }
DI float wsum(float v) { for (int o = 32; o > 0; o >>= 1) v += __shfl_xor(v, o); return v; }
DI float sigmoidf_(float x) { return 1.f / (1.f + __expf(-x)); }
DI float siluf_(float x) { return x / (1.f + __expf(-x)); }
DI float softplusf_(float x) { return x > 20.f ? x : log1pf(expf(x)); }
DI float logsigmoidf_(float x) { return fminf(x, 0.f) - log1pf(expf(-fabsf(x))); }
DI f32x16 zero16() { f32x16 z; for (int i = 0; i < 16; ++i) z[i] = 0.f; return z; }

DI const float* xrow_v(const float* xs, const float* xm, const float* xp, int r) {
  const bool smp = r >= NPR;
  const int b = (!smp && r >= TP) ? 1 : 0;
  const int t = r - b * TP;
  const bool met = !smp && t < 16;
  const float* base = smp ? xs : (met ? xm : xp);
  const int off = smp ? (r - NPR) : (met ? t : (b * 8192 + t - 16));
  return base + (size_t)off * D;
}
DI float* yrow_v(float* ys, float* ym, float* yp, int r) {
  const bool smp = r >= NPR;
  const int b = (!smp && r >= TP) ? 1 : 0;
  const int t = r - b * TP;
  const bool met = !smp && t < 16;
  float* base = smp ? ys : (met ? ym : yp);
  const int off = smp ? (r - NPR) : (met ? (b * 16 + t) : (b * 8192 + t - 16));
  return base + (size_t)off * D;
}
DI const float* xrow(const Params& p, int r) { const float* xs = p.x_sample; const float* xm = p.meta; const float* xp = p.x_prompt; return xrow_v(xs, xm, xp, r); }
DI float* yrow(const Params& p, int r) { float* o = p.out; unsigned char* w = p.ws; return yrow_v(o + O_YS, (float*)(w + W_YME), o + O_YP, r); }

#define XB_TMO      128
#define XB_XCNT(j)  (256  + 64 * (j))
#define XB_XSUB(j)  (1280 + 64 * (j))
#define XB_XGEN(j)  (2304 + 64 * (j))
#define XB_TOP      3328
#define XB_TOPGEN   3392
#define XCD_BAR_WORDS 3456
#define XB_SPIN_CAP (1u << 20)
#define LAS __attribute__((address_space(3)))
DI unsigned xb_ld(unsigned* p)              { return __hip_atomic_load(p, __ATOMIC_RELAXED, __HIP_MEMORY_SCOPE_AGENT); }
DI unsigned xb_add(unsigned* p, unsigned v) { return __hip_atomic_fetch_add(p, v, __ATOMIC_RELAXED, __HIP_MEMORY_SCOPE_AGENT); }
DI unsigned xb_xcc_id() { return (unsigned)__builtin_amdgcn_s_getreg((3 << 11) | 20) & 0xFu; }
#define XB_SPIN(cond, bar) do { unsigned _sp = 0; while (cond) { __builtin_amdgcn_s_sleep(3); \
    if ((++_sp & 255u) == 0u) { if (xb_ld(&(bar)[XB_TMO])) break; if (_sp > XB_SPIN_CAP) { atomicAdd(&(bar)[XB_TMO], 1u); break; } } } } while (0)
struct XcdBarrier { unsigned* bar; unsigned x; volatile LAS unsigned* st; };
DI XcdBarrier xcd_barrier_post(unsigned* bar, volatile LAS unsigned* st) {
  XcdBarrier b; b.bar = bar; b.x = xb_xcc_id(); b.st = st;
  if (threadIdx.x == 0) (void)xb_add(&bar[XB_XCNT(b.x)], 1u);
  return b;
}
DI void xcd_barrier_complete(unsigned* bar, unsigned x, unsigned& nloc, unsigned& nx) {
  const unsigned G = gridDim.x * gridDim.y * gridDim.z;
  unsigned sum, cnt, mine, sp = 0u;
  for (;;) {
    sum = 0u; cnt = 0u; mine = 0u;
#pragma unroll
    for (unsigned j = 0; j < 16; ++j) { const unsigned c = xb_ld(&bar[XB_XCNT(j)]); sum += c; cnt += (c > 0u) ? 1u : 0u; mine = (j == x) ? c : mine; }
    if (sum == G) break;
    __builtin_amdgcn_s_sleep(1);
    if ((++sp & 255u) == 0u) { if (xb_ld(&bar[XB_TMO])) break; if (sp > XB_SPIN_CAP) { atomicAdd(&bar[XB_TMO], 1u); break; } }
  }
  nloc = mine > 0u ? mine : 1u; nx = cnt > 0u ? cnt : 1u;
}
DI void xcd_barrier(const XcdBarrier& b) {
  asm volatile("s_waitcnt vmcnt(0)" ::: "memory");
  __syncthreads();
  if (threadIdx.x < 64 && b.st[0] == 0u) {
    const unsigned ln = threadIdx.x;
    const unsigned Gt = gridDim.x * gridDim.y * gridDim.z;
    unsigned c = 0u, sum = 0u, cnt = 0u, mine = 0u, sp = 0u;
    for (;;) {
      c = ln < 16u ? xb_ld(&b.bar[XB_XCNT(ln)]) : 0u;
      sum = c; cnt = c > 0u ? 1u : 0u; mine = (ln == b.x) ? c : 0u;
      for (int o = 32; o > 0; o >>= 1) { sum += __shfl_xor(sum, o); cnt += __shfl_xor(cnt, o); mine += __shfl_xor(mine, o); }
      if (sum == Gt || ++sp > XB_SPIN_CAP) break;
      __builtin_amdgcn_s_sleep(1);
    }
    if (ln == 0u) { b.st[1] = cnt > 0u ? cnt : 1u; b.st[0] = mine > 0u ? mine : 1u; }
  }
  if (threadIdx.x == 0) {
    unsigned* bar = b.bar;
    __builtin_amdgcn_s_waitcnt(0);
    unsigned nloc = b.st[0], nx = b.st[1];
    if (nloc == 0u) { xcd_barrier_complete(bar, b.x, nloc, nx); b.st[0] = nloc; b.st[1] = nx; }
    const unsigned old = xb_add(&bar[XB_XSUB(b.x)], 1u);
    const unsigned gen = old / nloc;
    if (old + 1u == (gen + 1u) * nloc) {
      __builtin_amdgcn_fence(__ATOMIC_RELEASE, "agent");
      asm volatile("s_waitcnt vmcnt(0)" ::: "memory");
      const unsigned og = xb_add(&bar[XB_TOP], 1u);
      const unsigned tg = og / nx;
      if (og + 1u == (tg + 1u) * nx) xb_add(&bar[XB_TOPGEN], 1u);
      else XB_SPIN(xb_ld(&bar[XB_TOPGEN]) == tg, bar);
      __builtin_amdgcn_fence(__ATOMIC_ACQUIRE, "agent");
      xb_add(&bar[XB_XGEN(b.x)], 1u);
      asm volatile("s_waitcnt vmcnt(0)" ::: "memory");
    } else {
      XB_SPIN(xb_ld(&bar[XB_XGEN(b.x)]) == gen, bar);
      __builtin_amdgcn_fence(__ATOMIC_ACQUIRE, "agent");
      asm volatile("s_waitcnt vmcnt(0)" ::: "memory");
    }
  }
  __syncthreads();
}

DI void wt_tile(const float* src, int ld, bf16_t* dst, int tile, float* tl) {
  int tid_o = threadIdx.x; asm volatile("" : "+v"(tid_o)); const int tid = tid_o;
  const int k0 = (tile & 15) * 64, n0 = (tile >> 4) * 64;
  float tv[16];
#pragma unroll
  for (int i = 0; i < 16; ++i) { const int idx = tid + 256 * i; const int kk = idx >> 6, nn = idx & 63; tv[i] = __builtin_nontemporal_load(src + (size_t)(k0 + kk) * ld + n0 + nn); }
#pragma unroll
  for (int i = 0; i < 16; ++i) { const int idx = tid + 256 * i; const int kk = idx >> 6, nn = idx & 63; tl[kk * 65 + nn] = tv[i]; }
  __syncthreads();
#pragma unroll
  for (int i = 0; i < 16; ++i) { const int idx = tid + 256 * i; const int nn = idx >> 6, kk = idx & 63; dst[(size_t)(n0 + nn) * 1024 + k0 + kk] = f2bf(tl[kk * 65 + nn]); }
  __syncthreads();
}

template <int NS, int LAYER>
DI void norm_phase(const Params& p, const float* g, const float* wsm, int ldw, int ncol0, bf16_t* hb, float* small, float* Ws) {
  int tid_o = threadIdx.x; asm volatile("" : "+v"(tid_o)); const int tid = tid_o, lane = tid & 63, wv = tid >> 6;
  __syncthreads();
  for (int i0 = tid; i0 < 1024 * NS; i0 += 256 * 8) {
    float wv8[8];
#pragma unroll
    for (int u = 0; u < 8; ++u) { const int i = i0 + 256 * u; wv8[u] = wsm[(size_t)(i / NS) * ldw + ncol0 + (i % NS)]; }
#pragma unroll
    for (int u = 0; u < 8; ++u) { const int i = i0 + 256 * u; Ws[(i % NS) * 1024 + (i / NS)] = wv8[u]; }
  }
  __syncthreads();
  float4 gv[4];
#pragma unroll
  for (int i = 0; i < 4; ++i) gv[i] = *(const float4*)(g + 4 * lane + 256 * i);
  const int stride = gridDim.x * 4;
  int r = blockIdx.x * 4 + wv;
  float4 xn[4];
  if (r < NROWS) { const float* xr = LAYER == 0 ? xrow(p, r) : (const float*)yrow(p, r);
#pragma unroll
    for (int i = 0; i < 4; ++i) xn[i] = nt_load4(xr + 4 * lane + 256 * i); }
  for (; r < MP; r += stride) {
    float4 xc[4];
#pragma unroll
    for (int i = 0; i < 4; ++i) xc[i] = xn[i];
    const int rn = r + stride;
    if (rn < NROWS) { const float* xr = LAYER == 0 ? xrow(p, rn) : (const float*)yrow(p, rn);
#pragma unroll
      for (int i = 0; i < 4; ++i) xn[i] = nt_load4(xr + 4 * lane + 256 * i); }
    if (r >= NROWS) {
#pragma unroll
      for (int i = 0; i < 4; ++i) *(s16x4*)(hb + (size_t)r * D + 4 * lane + 256 * i) = pack4(0.f, 0.f, 0.f, 0.f);
      if (lane < NS) small[(size_t)r * NS + lane] = 0.f;
      continue;
    }
    float ss = 0.f;
#pragma unroll
    for (int i = 0; i < 4; ++i) ss += xc[i].x * xc[i].x + xc[i].y * xc[i].y + xc[i].z * xc[i].z + xc[i].w * xc[i].w;
    ss = wsum(ss);
    const float rstd = rsqrtf(ss * (1.f / 1024.f) + EPS);
    float acc[NS];
#pragma unroll
    for (int c = 0; c < NS; ++c) acc[c] = 0.f;
#pragma unroll
    for (int i = 0; i < 4; ++i) {
      const float h0 = xc[i].x * rstd * gv[i].x, h1 = xc[i].y * rstd * gv[i].y, h2 = xc[i].z * rstd * gv[i].z, h3 = xc[i].w * rstd * gv[i].w;
      __builtin_nontemporal_store(pack4(h0, h1, h2, h3), (s16x4*)(hb + (size_t)r * D + 4 * lane + 256 * i));
#pragma unroll
      for (int c = 0; c < NS; ++c) { const float4 w4 = *(const float4*)(Ws + c * 1024 + 4 * lane + 256 * i); acc[c] += h0 * w4.x + h1 * w4.y + h2 * w4.z + h3 * w4.w; }
    }
#pragma unroll
    for (int c = 0; c < NS; ++c) acc[c] = wsum(acc[c]);
    if (lane == 0) { float4* so = (float4*)(small + (size_t)r * NS);
#pragma unroll
      for (int c4 = 0; c4 < NS / 4; ++c4) so[c4] = make_float4(acc[c4 * 4], acc[c4 * 4 + 1], acc[c4 * 4 + 2], acc[c4 * 4 + 3]); }
  }
  __syncthreads();
}

struct G8 { uint4 a0, a1, a2, a3, b0, b1, b2, b3; };
DI void gemm_gload(G8& g, const bf16_t* Ag, const bf16_t* Bg, int kt) {
  g.a0 = *(const uint4*)(Ag + kt * 64); g.a1 = *(const uint4*)(Ag + (size_t)32 * 1024 + kt * 64); g.a2 = *(const uint4*)(Ag + (size_t)64 * 1024 + kt * 64); g.a3 = *(const uint4*)(Ag + (size_t)96 * 1024 + kt * 64);
  g.b0 = *(const uint4*)(Bg + kt * 64); g.b1 = *(const uint4*)(Bg + (size_t)32 * 1024 + kt * 64); g.b2 = *(const uint4*)(Bg + (size_t)64 * 1024 + kt * 64); g.b3 = *(const uint4*)(Bg + (size_t)96 * 1024 + kt * 64);
}
DI void gemm_swrite(const G8& g, bf16_t* Asw, bf16_t* Bsw, int buf) {
  bf16_t* a = Asw + buf * 128 * 72; bf16_t* b = Bsw + buf * 128 * 72;
  *(uint4*)(a) = g.a0; *(uint4*)(a + 32 * 72) = g.a1; *(uint4*)(a + 64 * 72) = g.a2; *(uint4*)(a + 96 * 72) = g.a3;
  *(uint4*)(b) = g.b0; *(uint4*)(b + 32 * 72) = g.b1; *(uint4*)(b + 64 * 72) = g.b2; *(uint4*)(b + 96 * 72) = g.b3;
}
DI void gemm_comp(f32x16& c00, f32x16& c01, f32x16& c10, f32x16& c11, const bf16_t* Ab, const bf16_t* Bb, int co0, int co1, int co2, int co3) {
#define GK(CO) { bf16x8 a0 = *(const bf16x8*)(Ab + (CO)), a1 = *(const bf16x8*)(Ab + 32 * 64 + (CO)); bf16x8 b0 = *(const bf16x8*)(Bb + (CO)), b1 = *(const bf16x8*)(Bb + 32 * 64 + (CO)); \
    c00 = MFMA32(a0, b0, c00); c01 = MFMA32(a0, b1, c01); c10 = MFMA32(a1, b0, c10); c11 = MFMA32(a1, b1, c11); }
  GK(co0) GK(co1) GK(co2) GK(co3)
#undef GK
}
template <int EPI>
DI void gemm_tile(const Params& p, const bf16_t* __restrict__ A, const bf16_t* __restrict__ Bt, int m0, int n0, bf16_t* sm) {
  int tid_o = threadIdx.x; asm volatile("" : "+v"(tid_o)); const int tid = tid_o, lane = tid & 63, wv = tid >> 6, r = lane & 31, hh = lane >> 5;
  const int wm = wv >> 1, wn = wv & 1;
  bf16_t* As = sm;
  bf16_t* Bs = sm + 2 * 128 * 64;
  f32x16 c00 = zero16(), c01 = zero16(), c10 = zero16(), c11 = zero16();
  const int lrow = tid >> 3, lkc = (tid & 7) * 8;
  const bf16_t* Ag = A + (size_t)(m0 + lrow) * 1024 + lkc;
  const bf16_t* Bg = Bt + (size_t)(n0 + lrow) * 1024 + lkc;
  const int ch = tid & 7, swz = (lrow >> 1) & 7;
  bf16_t* Asw = As + lrow * 64 + ((ch ^ swz) << 3); bf16_t* Bsw = Bs + lrow * 64 + ((ch ^ swz) << 3);
  const int rk = (r >> 1) & 7;
  const bf16_t* Abase = As + (wm * 64 + r) * 64; const bf16_t* Bbase = Bs + (wn * 64 + r) * 64;
  const int co0 = ((0 + hh) ^ rk) << 3, co1 = ((2 + hh) ^ rk) << 3, co2 = ((4 + hh) ^ rk) << 3, co3 = ((6 + hh) ^ rk) << 3;
  uint4 pa0, pa1, pa2, pa3, pb0, pb1, pb2, pb3, qa0, qa1, qa2, qa3, qb0, qb1, qb2, qb3;
#define GLD(X, KT) X##a0 = *(const uint4*)(Ag + (KT) * 64); X##a1 = *(const uint4*)(Ag + 32 * 1024 + (KT) * 64); X##a2 = *(const uint4*)(Ag + 64 * 1024 + (KT) * 64); X##a3 = *(const uint4*)(Ag + 96 * 1024 + (KT) * 64); \
                   X##b0 = *(const uint4*)(Bg + (KT) * 64); X##b1 = *(const uint4*)(Bg + 32 * 1024 + (KT) * 64); X##b2 = *(const uint4*)(Bg + 64 * 1024 + (KT) * 64); X##b3 = *(const uint4*)(Bg + 96 * 1024 + (KT) * 64);
#define SWR(X, BUF) *(uint4*)(Asw + (BUF) * 8192) = X##a0; *(uint4*)(Asw + (BUF) * 8192 + 32 * 64) = X##a1; *(uint4*)(Asw + (BUF) * 8192 + 64 * 64) = X##a2; *(uint4*)(Asw + (BUF) * 8192 + 96 * 64) = X##a3; \
                    *(uint4*)(Bsw + (BUF) * 8192) = X##b0; *(uint4*)(Bsw + (BUF) * 8192 + 32 * 64) = X##b1; *(uint4*)(Bsw + (BUF) * 8192 + 64 * 64) = X##b2; *(uint4*)(Bsw + (BUF) * 8192 + 96 * 64) = X##b3;
  GLD(p, 0) GLD(q, 1)
  SWR(p, 0) __syncthreads();
  for (int kt = 0; kt < 16; kt += 2) {
    if (kt + 2 < 16) { GLD(p, kt + 2) }
    __builtin_amdgcn_sched_barrier(0);
    gemm_comp(c00, c01, c10, c11, Abase, Bbase, co0, co1, co2, co3);
    SWR(q, 1)
    __syncthreads();
    if (kt + 3 < 16) { GLD(q, kt + 3) }
    __builtin_amdgcn_sched_barrier(0);
    gemm_comp(c00, c01, c10, c11, Abase + 8192, Bbase + 8192, co0, co1, co2, co3);
    if (kt + 2 < 16) { SWR(p, 0) }
    __syncthreads();
  }
#undef GLD
#undef SWR
  f32x16 acc[2][2]; acc[0][0] = c00; acc[0][1] = c01; acc[1][0] = c10; acc[1][1] = c11;
  const float* xbs = p.x_sample; const float* xbm = p.meta; const float* xbp = p.x_prompt;
  float* ybs = p.out + O_YS; float* ybm = (float*)(p.ws + W_YME); float* ybp = p.out + O_YP;
  bf16_t* P = (bf16_t*)(p.ws + W_P);
  bf16_t* Pt = (bf16_t*)(p.ws + W_PT);
#pragma unroll
  for (int i = 0; i < 2; ++i)
#pragma unroll
    for (int j = 0; j < 2; ++j) {
      const int n = n0 + wn * 64 + 32 * j + r;
      const int mb = m0 + wm * 64 + 32 * i;
      if (EPI == 0 || EPI == 2) {
        const int ldp = EPI == 0 ? NA : NC;
#pragma unroll
        for (int q = 0; q < 16; ++q) P[(size_t)(mb + crow(q, hh)) * ldp + n] = f2bf(acc[i][j][q]);
        const int tlo = EPI == 0 ? 640 : 1024, thi = EPI == 0 ? 768 : 2048;
        if (n >= tlo && n < thi) {
#pragma unroll
          for (int gq = 0; gq < 4; ++gq)
            *(s16x4*)(Pt + (size_t)(n - tlo) * LDT + 128 + mb + 8 * gq + 4 * hh) = pack4(acc[i][j][4 * gq], acc[i][j][4 * gq + 1], acc[i][j][4 * gq + 2], acc[i][j][4 * gq + 3]);
        }
      } else {
        float* yp[16]; float rv[16];
#pragma unroll
        for (int q = 0; q < 16; ++q) {
          const int m = mb + crow(q, hh);
          const int mc = m < NROWS ? m : NROWS - 1;
          yp[q] = yrow_v(ybs, ybm, ybp, mc) + n;
          rv[q] = EPI == 1 ? __builtin_nontemporal_load(xrow_v(xbs, xbm, xbp, mc) + n) : __builtin_nontemporal_load(yp[q]);
        }
#pragma unroll
        for (int q = 0; q < 16; ++q) {
          const int m = mb + crow(q, hh);
          if (m < NROWS) *yp[q] = rv[q] + acc[i][j][q];
        }
      }
    }
}

template <int EPI>
DI void gemm_phase(const Params& p, const bf16_t* A, const bf16_t* Bt, int NT, bf16_t* sm, int wg0, int nwg) {
  constexpr int MT = MP / 128;
  const int x = wg0 & 7, w = wg0 >> 3, nw = nwg >> 3;
  const int mlo = (x * MT) >> 3, mhi = ((x + 1) * MT) >> 3, Mx = mhi - mlo;
  const int full = NT >> 3, rem = NT & 7, Tx = Mx * NT, fullT = full * 8 * Mx;
  for (int j = w; j < Tx; j += nw) {
    int mi, nt;
    if (j < fullT) { const int ng = j / (8 * Mx), jj = j - ng * 8 * Mx; mi = jj >> 3; nt = ng * 8 + (jj & 7); }
    else { const int jj = j - fullT; mi = jj / rem; nt = full * 8 + (jj - mi * rem); }
    gemm_tile<EPI>(p, A, Bt, (mlo + mi) * 128, nt * 128, sm);
  }
}

DI void swa_prompt_item(const Params& p, int item) {
  int tid_o = threadIdx.x; asm volatile("" : "+v"(tid_o)); const int tid = tid_o, lane = tid & 63, wv = tid >> 6, r = lane & 31, hh = lane >> 5;
  const int hd = item & 7; const int qb = (item >> 3) % 65; const int b = item / (8 * 65);
  const int kvh = hd >> 2;
  const bf16_t* P = (const bf16_t*)(p.ws + W_P);
  const bf16_t* Pt = (const bf16_t*)(p.ws + W_PT);
  bf16_t* M = (bf16_t*)(p.ws + W_M);
  const int tq = qb * 128 + wv * 32 + r;
  const int tqc = tq < TP ? tq : TP - 1;
  const int kb0 = qb * 128 - 128 + 32 * wv;
  bf16x8 qf[4];
  { const bf16_t* qp = P + (size_t)(b * TP + tqc) * NA + hd * 64 + 8 * hh;
    for (int ks = 0; ks < 4; ++ks) qf[ks] = *(const bf16x8*)(qp + 16 * ks); }
  f32x16 st[5];
#pragma unroll
  for (int j = 0; j < 5; ++j) {
    int kp = kb0 + 32 * j + r; kp = kp < 0 ? 0 : (kp > TP - 1 ? TP - 1 : kp);
    const bf16_t* kptr = P + (size_t)(b * TP + kp) * NA + 512 + kvh * 64 + 8 * hh;
    f32x16 a = zero16();
#pragma unroll
    for (int ks = 0; ks < 4; ++ks) { bf16x8 kf = *(const bf16x8*)(kptr + 16 * ks); a = MFMA32(kf, qf[ks], a); }
    st[j] = a;
  }
  const float sk = p.sink[hd];
  float mx = -1e30f;
#pragma unroll
  for (int j = 0; j < 5; ++j)
#pragma unroll
    for (int q = 0; q < 16; ++q) {
      int kp = kb0 + 32 * j + crow(q, hh); int df = tq - kp;
      bool ok = (kp >= 0) && (df >= 0) && (df < 128);
      float s = ok ? st[j][q] * 0.125f : -1e30f;
      st[j][q] = s; mx = fmaxf(mx, s);
    }
  mx = fmaxf(mx, __shfl_xor(mx, 32));
  mx = fmaxf(mx, sk);
  float sum = 0.f;
#pragma unroll
  for (int j = 0; j < 5; ++j)
#pragma unroll
    for (int q = 0; q < 16; ++q) { float s = st[j][q]; float e = s > -1e29f ? __expf(s - mx) : 0.f; st[j][q] = e; sum += e; }
  sum += __shfl_xor(sum, 32);
  const float inv = 1.f / (sum + __expf(sk - mx));
  f32x16 ot[2]; ot[0] = zero16(); ot[1] = zero16();
#pragma unroll
  for (int j = 0; j < 5; ++j)
#pragma unroll
    for (int s = 0; s < 2; ++s) {
      bf16x8 pf;
#pragma unroll
      for (int e = 0; e < 8; ++e) pf[e] = (short)f2bf(st[j][8 * s + e]);
      const int kidx = 128 + b * TP + kb0 + 32 * j + 16 * s + 4 * hh;
#pragma unroll
      for (int dt = 0; dt < 2; ++dt) {
        const bf16_t* vp = Pt + (size_t)(kvh * 64 + dt * 32 + r) * LDT + kidx;
        s16x4 lo = *(const s16x4*)(vp), hi = *(const s16x4*)(vp + 8);
        bf16x8 vf = __builtin_shufflevector(lo, hi, 0, 1, 2, 3, 4, 5, 6, 7);
        ot[dt] = MFMA32(vf, pf, ot[dt]);
      }
    }
  if (tq < TP) {
    const size_t row = (size_t)(b * TP + tq);
#pragma unroll
    for (int dt = 0; dt < 2; ++dt)
#pragma unroll
      for (int gq = 0; gq < 4; ++gq) {
        const int d = dt * 32 + 8 * gq + 4 * hh;
        s16x4 z4 = *(const s16x4*)(P + row * NA + 768 + hd * 64 + d);
        float o0 = ot[dt][4 * gq] * inv * siluf_(bf2f((bf16_t)z4[0]));
        float o1 = ot[dt][4 * gq + 1] * inv * siluf_(bf2f((bf16_t)z4[1]));
        float o2 = ot[dt][4 * gq + 2] * inv * siluf_(bf2f((bf16_t)z4[2]));
        float o3 = ot[dt][4 * gq + 3] * inv * siluf_(bf2f((bf16_t)z4[3]));
        *(s16x4*)(M + row * 1024 + hd * 64 + d) = pack4(o0, o1, o2, o3);
      }
  }
}

DI void swa_sample_item(const Params& p, int b, float* smf) {
  int tid_o = threadIdx.x; asm volatile("" : "+v"(tid_o)); const int tid = tid_o, lane = tid & 63, wv = tid >> 6;
  float* kbuf = smf;
  float* sc = smf + 128 * 129;
  float* qsh = sc + 8 * 128;
  const bf16_t* P = (const bf16_t*)(p.ws + W_P);
  bf16_t* M = (bf16_t*)(p.ws + W_M);
  const size_t row = (size_t)(NPR + b);
  const bf16_t* pr = P + row * NA;
  __syncthreads();
  for (int i = tid; i < 512; i += 256) qsh[i] = bf2f(pr[i]);
  {
    const float4* src = (const float4*)(p.cache_k + (size_t)b * 16384 + 128);
    float4* dst = (float4*)(p.out + O_SKS + (size_t)b * 16384);
    float4 cv[16];
#pragma unroll
    for (int j = 0; j < 16; ++j) { const int i4 = tid + 256 * j; cv[j] = nt_load4((const float*)(src + (i4 < 127 * 32 ? i4 : 0))); }
#pragma unroll
    for (int j = 0; j < 16; ++j) { const int i4 = tid + 256 * j; if (i4 < 127 * 32) { const float4 v = cv[j]; nt_store4((float*)(dst + i4), v); float* kb = kbuf + (i4 >> 5) * 129 + (i4 & 31) * 4; kb[0] = v.x; kb[1] = v.y; kb[2] = v.z; kb[3] = v.w; } }
    if (tid < 128) { const float v = bf2f(pr[512 + tid]); p.out[O_SKS + (size_t)b * 16384 + 127 * 128 + tid] = v; kbuf[127 * 129 + tid] = v; }
  }
  __syncthreads();
  { const int kk = tid & 127, kvh = tid >> 7;
    float d0 = 0.f, d1 = 0.f, d2 = 0.f, d3 = 0.f;
    for (int d = 0; d < 64; ++d) { float kv = kbuf[kk * 129 + kvh * 64 + d]; const float* qq = qsh + kvh * 256 + d; d0 += qq[0] * kv; d1 += qq[64] * kv; d2 += qq[128] * kv; d3 += qq[192] * kv; }
    sc[(kvh * 4 + 0) * 128 + kk] = d0 * 0.125f; sc[(kvh * 4 + 1) * 128 + kk] = d1 * 0.125f; sc[(kvh * 4 + 2) * 128 + kk] = d2 * 0.125f; sc[(kvh * 4 + 3) * 128 + kk] = d3 * 0.125f; }
  __syncthreads();
  for (int hq = 0; hq < 2; ++hq) {
    const int h = wv * 2 + hq; const float sk = p.sink[h];
    float s0 = sc[h * 128 + lane], s1 = sc[h * 128 + lane + 64];
    float m = fmaxf(s0, s1); for (int o = 32; o > 0; o >>= 1) m = fmaxf(m, __shfl_xor(m, o)); m = fmaxf(m, sk);
    float e0 = __expf(s0 - m), e1 = __expf(s1 - m); float sum = wsum(e0 + e1);
    float inv = 1.f / (sum + __expf(sk - m));
    sc[h * 128 + lane] = e0 * inv; sc[h * 128 + lane + 64] = e1 * inv;
  }
  __syncthreads();
  {
    const float4* src = (const float4*)(p.cache_v + (size_t)b * 16384 + 128);
    float4* dst = (float4*)(p.out + O_SVS + (size_t)b * 16384);
    float4 cv[16];
#pragma unroll
    for (int j = 0; j < 16; ++j) { const int i4 = tid + 256 * j; cv[j] = nt_load4((const float*)(src + (i4 < 127 * 32 ? i4 : 0))); }
#pragma unroll
    for (int j = 0; j < 16; ++j) { const int i4 = tid + 256 * j; if (i4 < 127 * 32) { const float4 v = cv[j]; nt_store4((float*)(dst + i4), v); float* kb = kbuf + (i4 >> 5) * 129 + (i4 & 31) * 4; kb[0] = v.x; kb[1] = v.y; kb[2] = v.z; kb[3] = v.w; } }
    if (tid < 128) { const float v = bf2f(pr[640 + tid]); p.out[O_SVS + (size_t)b * 16384 + 127 * 128 + tid] = v; kbuf[127 * 129 + tid] = v; }
  }
  __syncthreads();
  { const int h = tid >> 5, d0 = (tid & 31) * 2, kvh = h >> 2;
    float o0 = 0.f, o1 = 0.f;
    for (int kk = 0; kk < 128; ++kk) { float pp = sc[h * 128 + kk]; o0 += pp * kbuf[kk * 129 + kvh * 64 + d0]; o1 += pp * kbuf[kk * 129 + kvh * 64 + d0 + 1]; }
    float z0 = bf2f(pr[768 + h * 64 + d0]), z1 = bf2f(pr[768 + h * 64 + d0 + 1]);
    M[row * 1024 + h * 64 + d0] = f2bf(o0 * siluf_(z0)); M[row * 1024 + h * 64 + d0 + 1] = f2bf(o1 * siluf_(z1)); }
  __syncthreads();
}

DI void dn_sample_item(const Params& p, int item, float* smf) {
  int tid_o = threadIdx.x; asm volatile("" : "+v"(tid_o)); const int tid = tid_o;
  const int b = item >> 2, h = item & 3;
  float* qv = smf; float* kv = smf + 128; float* vv = smf + 256; float* part = smf + 384;
  float* red = part + 1024;
  const bf16_t* P = (const bf16_t*)(p.ws + W_P);
  bf16_t* M = (bf16_t*)(p.ws + W_M);
  const float* sm0 = (const float*)(p.ws + W_SM0);
  const size_t row = (size_t)(NPR + b);
  __syncthreads();
  for (int c = tid; c < 384; c += 256) {
    const int seg = c >> 7, j = c & 127; const int ch = seg * 512 + h * 128 + j;
    const float* cs = p.st_conv + (size_t)b * 3 * 1536 + ch;
    float x0 = cs[0], x1 = cs[1536], x2 = cs[3072], x3 = bf2f(P[row * NA + 1280 + ch]);
    float y = x0 * p.conv_b[ch] + x1 * p.conv_b[1536 + ch] + x2 * p.conv_b[3072 + ch] + x3 * p.conv_b[4608 + ch];
    y = siluf_(y);
    smf[seg * 128 + j] = y;
    float* oc = p.out + O_CVS + (size_t)b * 3 * 1536 + ch; oc[0] = x1; oc[1536] = x2; oc[3072] = x3;
  }
  __syncthreads();
  float ssq = 0.f, ssk = 0.f;
#pragma unroll 4
  for (int i = 0; i < 128; ++i) { float a = qv[i], c = kv[i]; ssq += a * a; ssk += c * c; }
  const float qsc = rsqrtf(ssq + EPS) * 0.08838834764831845f, ksc = rsqrtf(ssk + EPS);
  const float beta = sigmoidf_(sm0[row * 8 + h]);
  const float g = -expf(p.a_log[h]) * softplusf_(sm0[row * 8 + 4 + h] + p.dt_bias[h]);
  const float eg = expf(g);
  const int v4 = (tid & 31) * 4, kg = tid >> 5;
  const float* Sg = p.st_dn + ((size_t)(b * 4 + h) * 128) * 128;
  float4 ps = make_float4(0.f, 0.f, 0.f, 0.f);
  float4 Sv[16];
#pragma unroll
  for (int i = 0; i < 16; ++i) Sv[i] = nt_load4(Sg + (kg + 8 * i) * 128 + v4);
#pragma unroll
  for (int i = 0; i < 16; ++i) { const int k = kg + 8 * i; float kk = kv[k] * ksc; ps.x += kk * Sv[i].x; ps.y += kk * Sv[i].y; ps.z += kk * Sv[i].z; ps.w += kk * Sv[i].w; }
  *(float4*)(part + kg * 128 + v4) = ps;
  __syncthreads();
  if (tid < 128) { float s = 0.f; for (int gI = 0; gI < 8; ++gI) s += part[gI * 128 + tid]; red[tid] = beta * (vv[tid] - eg * s); }
  __syncthreads();
  float4 vn = *(const float4*)(red + v4); float4 po = make_float4(0.f, 0.f, 0.f, 0.f);
  float* So = p.out + O_DNS + ((size_t)(b * 4 + h) * 128) * 128;
#pragma unroll
  for (int i = 0; i < 16; ++i) {
    const int k = kg + 8 * i; const float kk = kv[k] * ksc, qq = qv[k] * qsc;
    float4 s = Sv[i]; s.x = eg * s.x + kk * vn.x; s.y = eg * s.y + kk * vn.y; s.z = eg * s.z + kk * vn.z; s.w = eg * s.w + kk * vn.w;
    nt_store4(So + k * 128 + v4, s);
    po.x += qq * s.x; po.y += qq * s.y; po.z += qq * s.z; po.w += qq * s.w;
  }
  __syncthreads();
  *(float4*)(part + kg * 128 + v4) = po;
  __syncthreads();
  if (tid < 128) { float s = 0.f; for (int gI = 0; gI < 8; ++gI) s += part[gI * 128 + tid]; M[row * 1024 + 512 + h * 128 + tid] = f2bf(s); }
  __syncthreads();
}

DI void gla_sample_item(const Params& p, int item, float* smf) {
  int tid_o = threadIdx.x; asm volatile("" : "+v"(tid_o)); const int tid = tid_o;
  const int vh = item & 1, h = (item >> 1) & 3, b = item >> 3;
  float* qv = smf; float* kv = smf + 128; float* av = smf + 256; float* vv = smf + 384; float* part = smf + 512;
  const bf16_t* P = (const bf16_t*)(p.ws + W_P);
  bf16_t* M = (bf16_t*)(p.ws + W_M);
  const float* sm1 = (const float*)(p.ws + W_SM1);
  const size_t row = (size_t)(NPR + b);
  __syncthreads();
  if (tid < 128) {
    const int k = tid;
    qv[k] = bf2f(P[row * NC + h * 128 + k]) * 0.08838834764831845f;
    kv[k] = bf2f(P[row * NC + 512 + h * 128 + k]);
    float a = p.b_gk[h * 128 + k];
    float g16[16], w16[16];
#pragma unroll
    for (int rr = 0; rr < 16; ++rr) { g16[rr] = sm1[row * 16 + rr]; w16[rr] = p.w_gk_up[rr * 512 + h * 128 + k]; }
#pragma unroll
    for (int rr = 0; rr < 16; ++rr) a += g16[rr] * w16[rr];
    av[k] = expf(logsigmoidf_(a) * (1.f / 16.f));
  } else {
    const int v = tid - 128;
    vv[v] = bf2f(P[row * NC + 1024 + h * 256 + vh * 128 + v]);
  }
  __syncthreads();
  float qk = 0.f;
#pragma unroll 4
  for (int i = 0; i < 128; ++i) qk += qv[i] * kv[i];
  const int v4 = (tid & 31) * 4, kg = tid >> 5;
  const float* Sg = p.st_gla + ((size_t)(b * 4 + h) * 128) * 256 + vh * 128;
  float* So = p.out + O_GLS + ((size_t)(b * 4 + h) * 128) * 256 + vh * 128;
  const float4 v = *(const float4*)(vv + v4);
  float4 po = make_float4(0.f, 0.f, 0.f, 0.f);
  float4 Sv[16];
#pragma unroll
  for (int i = 0; i < 16; ++i) Sv[i] = nt_load4(Sg + (size_t)(kg + 8 * i) * 256 + v4);
#pragma unroll
  for (int i = 0; i < 16; ++i) {
    const int k = kg + 8 * i;
    float4 s = Sv[i];
    const float a = av[k], kk = kv[k], qq = qv[k];
    s.x = a * s.x + kk * v.x; s.y = a * s.y + kk * v.y; s.z = a * s.z + kk * v.z; s.w = a * s.w + kk * v.w;
    nt_store4(So + (size_t)k * 256 + v4, s);
    po.x += qq * s.x; po.y += qq * s.y; po.z += qq * s.z; po.w += qq * s.w;
  }
  (void)qk;
  *(float4*)(part + kg * 128 + v4) = po;
  __syncthreads();
  if (tid < 128) { float s = 0.f; for (int gI = 0; gI < 8; ++gI) s += part[gI * 128 + tid]; M[row * 1024 + h * 256 + vh * 128 + tid] = f2bf(s); }
  __syncthreads();
}

template <int I, int HF>
DI void inv_seg(float (&T)[64], float4 (&an)[8], const float4* Am4, float& a0, float& a1, float& a2, float& a3) {
  constexpr int jlo = HF * 32, jhi = HF == 0 ? (I < 32 ? I : 32) : I;
  constexpr int nq = (jhi - jlo + 3) / 4;
  float4 ac[nq];
#pragma unroll
  for (int q = 0; q < nq; ++q) ac[q] = an[q];
  if (HF == 0 && I > 32) {
    constexpr int n2 = (I - 32 + 3) / 4;
#pragma unroll
    for (int q = 0; q < (n2 > 0 ? n2 : 1); ++q) if (q < n2) an[q] = Am4[I * 16 + 8 + q];
  } else if (I + 1 < 64) {
    constexpr int n2 = ((I + 1 < 32 ? I + 1 : 32) + 3) / 4;
#pragma unroll
    for (int q = 0; q < n2; ++q) an[q] = Am4[(I + 1) * 16 + q];
  }
  __builtin_amdgcn_sched_barrier(0);
#pragma unroll
  for (int j = jlo; j < jhi; ++j) {
    const float4 v4 = ac[(j - jlo) >> 2];
    if ((j & 3) == 0) a0 -= v4.x * T[j]; else if ((j & 3) == 1) a1 -= v4.y * T[j]; else if ((j & 3) == 2) a2 -= v4.z * T[j]; else a3 -= v4.w * T[j];
  }
  __builtin_amdgcn_sched_barrier(0);
}
template <int I>
DI void inv_row(float (&T)[64], float4 (&an)[8], const float4* Am4, int lane) {
  float a0 = (lane == I) ? 1.f : 0.f, a1 = 0.f, a2 = 0.f, a3 = 0.f;
  inv_seg<I, 0>(T, an, Am4, a0, a1, a2, a3);
  if constexpr (I > 32) inv_seg<I, 1>(T, an, Am4, a0, a1, a2, a3);
  T[I] = (a0 + a1) + (a2 + a3);
}
template <int... Is>
DI void inv_all(float (&T)[64], float4 (&an)[8], const float4* Am4, int lane, std::integer_sequence<int, Is...>) { (inv_row<Is + 1>(T, an, Am4, lane), ...); }

DI void dn_prep_item(const Params& p, int ci, unsigned char* smem) {
  int tid_o = threadIdx.x; asm volatile("" : "+v"(tid_o)); const int tid = tid_o, lane = tid & 63, wv = tid >> 6, r = lane & 31, hh = lane >> 5;
  const int n = ci % NCH, bh = ci / NCH, b = bh >> 2, h = bh & 3;
  bf16_t* qs = (bf16_t*)smem;
  bf16_t* ks = qs + 64 * 136;
  bf16_t* kgT = ks + 64 * 136;
  bf16_t* vbT = kgT + 128 * 72;
  float* gcs = (float*)(vbT + 128 * 72);
  float* bts = gcs + 64;
  float* Am = (float*)qs;
  bf16_t* Tb = ks;
  const bf16_t* P = (const bf16_t*)(p.ws + W_P);
  const float* sm0 = (const float*)(p.ws + W_SM0);
  unsigned char* C0 = p.ws + W_C0;
  bf16_t* Cw = (bf16_t*)(C0 + C0_W) + (size_t)ci * 8192;
  bf16_t* CuT = (bf16_t*)(C0 + C0_UT) + (size_t)ci * 8192;
  bf16_t* Cqd = (bf16_t*)(C0 + C0_QD) + (size_t)ci * 8192;
  bf16_t* CkdT = (bf16_t*)(C0 + C0_KDT) + (size_t)ci * 8192;
  bf16_t* Cqk = (bf16_t*)(C0 + C0_QK) + (size_t)ci * 4096;
  float* Cgl = (float*)(p.ws + W_DGL);
  const int t0 = 64 * n - 48;
  __syncthreads();
  if (wv == 0) {
    const int t = t0 + lane; float beta = 0.f, g = 0.f;
    if (t >= 0) { const size_t rr = (size_t)(b * TP + t); beta = sigmoidf_(sm0[rr * 8 + h]); g = -expf(p.a_log[h]) * softplusf_(sm0[rr * 8 + 4 + h] + p.dt_bias[h]); }
    float c = g;
    for (int o = 1; o < 64; o <<= 1) { float u = __shfl_up(c, o); if (lane >= o) c += u; }
    gcs[lane] = c; bts[lane] = beta;
  }
  __syncthreads();
  {
    float cw[3][2][4];
#pragma unroll
    for (int sg = 0; sg < 3; ++sg)
#pragma unroll
      for (int e = 0; e < 2; ++e)
#pragma unroll
        for (int d = 0; d < 4; ++d) cw[sg][e][d] = p.conv_b[d * 1536 + sg * 512 + h * 128 + 2 * lane + e];
#pragma unroll 1
    for (int g4 = 0; g4 < 4; ++g4) {
      const int ib = wv * 16 + g4 * 4;
      unsigned xr[7][3];
#pragma unroll
      for (int rr = 0; rr < 7; ++rr) {
        int t = t0 + ib - 3 + rr; t = t < 0 ? 0 : t;
        const bf16_t* pp = P + (size_t)(b * TP + t) * NA + 1280 + h * 128 + 2 * lane;
#pragma unroll
        for (int sg = 0; sg < 3; ++sg) xr[rr][sg] = *(const unsigned*)(pp + sg * 512);
      }
#pragma unroll
      for (int ii = 0; ii < 4; ++ii) {
        const int i = ib + ii;
        float y[3][2];
#pragma unroll
        for (int sg = 0; sg < 3; ++sg)
#pragma unroll
          for (int e = 0; e < 2; ++e) {
            float a = 0.f;
#pragma unroll
            for (int d = 0; d < 4; ++d) {
              const int tt = t0 + i - 3 + d;
              const unsigned w = xr[ii + d][sg];
              const float xv = __uint_as_float(e == 0 ? (w << 16) : (w & 0xffff0000u));
              a += (tt >= 0 ? xv : 0.f) * cw[sg][e][d];
            }
            y[sg][e] = siluf_(a);
          }
        const float ssq = wsum(y[0][0] * y[0][0] + y[0][1] * y[0][1]);
        const float ssk = wsum(y[1][0] * y[1][0] + y[1][1] * y[1][1]);
        const float qsc = rsqrtf(ssq + EPS) * 0.08838834764831845f, ksc = rsqrtf(ssk + EPS);
        const float gci = gcs[i], bi = bts[i], egi = expf(gci);
        const float q0 = y[0][0] * qsc, q1 = y[0][1] * qsc, k0 = y[1][0] * ksc, k1 = y[1][1] * ksc;
        *(unsigned*)(qs + i * 136 + 2 * lane) = (unsigned)f2bf(q0) | ((unsigned)f2bf(q1) << 16);
        *(unsigned*)(ks + i * 136 + 2 * lane) = (unsigned)f2bf(k0) | ((unsigned)f2bf(k1) << 16);
        kgT[(2 * lane) * 72 + i] = f2bf(k0 * bi * egi); kgT[(2 * lane + 1) * 72 + i] = f2bf(k1 * bi * egi);
        vbT[(2 * lane) * 72 + i] = f2bf(y[2][0] * bi); vbT[(2 * lane + 1) * 72 + i] = f2bf(y[2][1] * bi);
        *(unsigned*)(Cqd + i * 128 + 2 * lane) = (unsigned)f2bf(q0 * egi) | ((unsigned)f2bf(q1 * egi) << 16);
      }
    }
  }
  __syncthreads();
  f32x16 akk = zero16(), aqk = zero16();
  const int mi = wv >> 1, nj = wv & 1;
  {
    const bf16_t* ap = ks + (32 * mi + r) * 136 + 8 * hh;
    const bf16_t* qp = qs + (32 * mi + r) * 136 + 8 * hh;
    const bf16_t* bp = ks + (32 * nj + r) * 136 + 8 * hh;
#pragma unroll
    for (int s = 0; s < 8; ++s) {
      bf16x8 bb = *(const bf16x8*)(bp + 16 * s);
      akk = MFMA32(*(const bf16x8*)(ap + 16 * s), bb, akk);
      aqk = MFMA32(*(const bf16x8*)(qp + 16 * s), bb, aqk);
    }
  }
  __syncthreads();
  {
    const int j = 32 * nj + r; const float gcj = gcs[j];
#pragma unroll
    for (int q = 0; q < 16; ++q) {
      const int i = 32 * mi + crow(q, hh);
      const float dec = i >= j ? expf(gcs[i] - gcj) : 0.f;
      Am[i * 64 + j] = i > j ? bts[i] * akk[q] * dec : 0.f;
      Cqk[i * 64 + j] = f2bf(aqk[q] * dec);
    }
  }
  {
    const float gl = gcs[63];
    for (int e = tid; e < 128 * 16; e += 256) {
      const int k = e >> 4, i4 = (e & 15) * 4;
      float v0 = bf2f(ks[(i4 + 0) * 136 + k]) * expf(gl - gcs[i4 + 0]);
      float v1 = bf2f(ks[(i4 + 1) * 136 + k]) * expf(gl - gcs[i4 + 1]);
      float v2 = bf2f(ks[(i4 + 2) * 136 + k]) * expf(gl - gcs[i4 + 2]);
      float v3 = bf2f(ks[(i4 + 3) * 136 + k]) * expf(gl - gcs[i4 + 3]);
      *(s16x4*)(CkdT + k * 64 + i4) = pack4(v0, v1, v2, v3);
    }
    if (tid == 0) Cgl[ci] = expf(gl);
  }
  __syncthreads();
  if (wv == 0) {
    float T[64];
    const float4* Am4 = (const float4*)Am;
    T[0] = (lane == 0) ? 1.f : 0.f;
    float4 an[8];
    an[0] = Am4[16];
    inv_all(T, an, Am4, lane, std::make_integer_sequence<int, 63>{});
#pragma unroll
    for (int i = 0; i < 64; ++i) Tb[i * 72 + lane] = f2bf(T[i]);
  }
  __syncthreads();
  {
#pragma unroll
    for (int mt = 0; mt < 2; ++mt) {
      f32x16 au = zero16(), aw = zero16();
#pragma unroll
      for (int s = 0; s < 4; ++s) {
        bf16x8 tf = *(const bf16x8*)(Tb + (32 * mt + r) * 72 + 16 * s + 8 * hh);
        bf16x8 vf = *(const bf16x8*)(vbT + (32 * wv + r) * 72 + 16 * s + 8 * hh);
        bf16x8 kf = *(const bf16x8*)(kgT + (32 * wv + r) * 72 + 16 * s + 8 * hh);
        au = MFMA32(tf, vf, au);
        aw = MFMA32(kf, tf, aw);
      }
#pragma unroll
      for (int gq = 0; gq < 4; ++gq) {
        *(s16x4*)(CuT + (32 * wv + r) * 64 + 32 * mt + 8 * gq + 4 * hh) = pack4(au[4 * gq], au[4 * gq + 1], au[4 * gq + 2], au[4 * gq + 3]);
        *(s16x4*)(Cw + (32 * mt + r) * 128 + 32 * wv + 8 * gq + 4 * hh) = pack4(aw[4 * gq], aw[4 * gq + 1], aw[4 * gq + 2], aw[4 * gq + 3]);
      }
    }
  }
  __syncthreads();
}

struct DnRegs { bf16x8 a1[8]; bf16x8 akd[4]; bf16x8 aqk[4]; s16x4 u[4]; float gl; };
DI void dn_load_a(const Params& p, DnRegs& R, int ci, int cb, int wv, int r, int hh) {
  unsigned char* C0 = p.ws + W_C0;
  const bf16_t* A1 = (const bf16_t*)(C0 + (wv < 2 ? C0_W : C0_QD)) + (size_t)ci * 8192 + (32 * (wv & 1) + r) * 128 + 8 * hh;
#pragma unroll
  for (int s = 0; s < 8; ++s) R.a1[s] = *(const bf16x8*)(A1 + 16 * s);
  if (wv < 2) {
    const bf16_t* U = (const bf16_t*)(C0 + C0_UT) + (size_t)ci * 8192 + (cb * 32 + r) * 64 + 32 * (wv & 1) + 4 * hh;
#pragma unroll
    for (int gq = 0; gq < 4; ++gq) R.u[gq] = *(const s16x4*)(U + 8 * gq);
  }
}
DI void dn_load_b(const Params& p, DnRegs& R, int ci, int cb, int wv, int r, int hh) {
  unsigned char* C0 = p.ws + W_C0;
  const bf16_t* Akd = (const bf16_t*)(C0 + C0_KDT) + (size_t)ci * 8192 + (32 * wv + r) * 64 + 8 * hh;
#pragma unroll
  for (int s = 0; s < 4; ++s) R.akd[s] = *(const bf16x8*)(Akd + 16 * s);
  if (wv >= 2) {
    const bf16_t* Aqk = (const bf16_t*)(C0 + C0_QK) + (size_t)ci * 4096 + (32 * (wv & 1) + r) * 64 + 8 * hh;
#pragma unroll
    for (int s = 0; s < 4; ++s) R.aqk[s] = *(const bf16x8*)(Aqk + 16 * s);
  }
  R.gl = ((const float*)(p.ws + W_DGL))[ci];
}
DI void dn_scan_item(const Params& p, int item, unsigned char* smem) {
  int tid_o = threadIdx.x; asm volatile("" : "+v"(tid_o)); const int tid = tid_o, lane = tid & 63, wv = tid >> 6, r = lane & 31, hh = lane >> 5;
  const int bh = item & 7, j_ = item >> 3; const int cb = j_ & 3, g = j_ >> 2, b = bh >> 2, h = bh & 3;
  const int n0 = 3 * g, n1 = n0 + 3;
  bf16_t* SbT = (bf16_t*)smem;
  bf16_t* vnT = SbT + 32 * 136;
  bf16_t* M = (bf16_t*)(p.ws + W_M);
  f32x16 S;
  DnRegs R;
  dn_load_a(p, R, bh * NCH + n0, cb, wv, r, hh);
  dn_load_b(p, R, bh * NCH + n0, cb, wv, r, hh);
  { const float* Sn = p.out + O_GLS + ((size_t)(bh * DN_NG + g) * 128) * 128;
#pragma unroll
    for (int q = 0; q < 16; ++q) S[q] = Sn[(32 * wv + crow(q, hh)) * 128 + cb * 32 + r]; }
  __syncthreads();
  for (int n = n0; n < n1; ++n) {
    const int cin = bh * NCH + (n + 1 < n1 ? n + 1 : n);
#pragma unroll
    for (int gq = 0; gq < 4; ++gq) *(s16x4*)(SbT + r * 136 + 32 * wv + 8 * gq + 4 * hh) = pack4(S[4 * gq], S[4 * gq + 1], S[4 * gq + 2], S[4 * gq + 3]);
    __syncthreads();
    f32x16 acc = zero16();
#pragma unroll
    for (int s = 0; s < 8; ++s) acc = MFMA32(R.a1[s], *(const bf16x8*)(SbT + r * 136 + 16 * s + 8 * hh), acc);
    if (wv < 2) {
#pragma unroll
      for (int gq = 0; gq < 4; ++gq) {
        float v0 = bf2f((bf16_t)R.u[gq][0]) - acc[4 * gq], v1 = bf2f((bf16_t)R.u[gq][1]) - acc[4 * gq + 1];
        float v2 = bf2f((bf16_t)R.u[gq][2]) - acc[4 * gq + 2], v3 = bf2f((bf16_t)R.u[gq][3]) - acc[4 * gq + 3];
        *(s16x4*)(vnT + r * 72 + 32 * (wv & 1) + 8 * gq + 4 * hh) = pack4(v0, v1, v2, v3);
      }
    }
    dn_load_a(p, R, cin, cb, wv, r, hh);
    __syncthreads();
    bf16x8 bv[4];
#pragma unroll
    for (int s = 0; s < 4; ++s) bv[s] = *(const bf16x8*)(vnT + r * 72 + 16 * s + 8 * hh);
#pragma unroll
    for (int q = 0; q < 16; ++q) S[q] *= R.gl;
#pragma unroll
    for (int s = 0; s < 4; ++s) S = MFMA32(R.akd[s], bv[s], S);
    if (wv >= 2) {
#pragma unroll
      for (int s = 0; s < 4; ++s) acc = MFMA32(R.aqk[s], bv[s], acc);
      const int tb = 64 * n - 48 + 32 * (wv & 1);
#pragma unroll
      for (int q = 0; q < 16; ++q) {
        const int t = tb + crow(q, hh);
        if (t >= 0) M[(size_t)(b * TP + t) * 1024 + 512 + h * 128 + cb * 32 + r] = f2bf(acc[q]);
      }
    }
    dn_load_b(p, R, cin, cb, wv, r, hh);
  }
  __syncthreads();
}

struct DnSt { u32x4 w0, w1, w2, w3, k0, k1, k2, k3, u0; float gl; };
DI void dn_l1_load(const Params& p, DnSt& R, int ci, int cb, int tid) {
  unsigned char* C0 = p.ws + W_C0;
  const u32x4* W4 = (const u32x4*)(C0 + C0_W + (size_t)ci * 16384) + tid;
  R.w0 = W4[0]; R.w1 = W4[256]; R.w2 = W4[512]; R.w3 = W4[768];
  const u32x4* K4 = (const u32x4*)(C0 + C0_KDT + (size_t)ci * 16384) + tid;
  R.k0 = K4[0]; R.k1 = K4[256]; R.k2 = K4[512]; R.k3 = K4[768];
  R.u0 = ((const u32x4*)(C0 + C0_UT + (size_t)ci * 16384 + (size_t)cb * 4096))[tid];
  R.gl = ((const float*)(p.ws + W_DGL))[ci];
}
DI void dn_l1_step(const DnSt& R, f32x16& S, unsigned char* smem, int tid, int lane, int wv, int r, int hh) {
  bf16_t* SbT = (bf16_t*)smem;
  bf16_t* vnT = SbT + 32 * 136;
  float4* part = (float4*)(smem + 16384);
  bf16_t* Wl = (bf16_t*)(smem + 24576);
  bf16_t* Kl = (bf16_t*)(smem + 41984);
  bf16_t* Ul = (bf16_t*)(smem + 60416);
  {
    const int i0 = tid, i1 = tid + 256, i2 = tid + 512, i3 = tid + 768;
    *(u32x4*)(Wl + (i0 >> 4) * 136 + (i0 & 15) * 8) = R.w0; *(u32x4*)(Wl + (i1 >> 4) * 136 + (i1 & 15) * 8) = R.w1;
    *(u32x4*)(Wl + (i2 >> 4) * 136 + (i2 & 15) * 8) = R.w2; *(u32x4*)(Wl + (i3 >> 4) * 136 + (i3 & 15) * 8) = R.w3;
    *(u32x4*)(Kl + (i0 >> 3) * 72 + (i0 & 7) * 8) = R.k0; *(u32x4*)(Kl + (i1 >> 3) * 72 + (i1 & 7) * 8) = R.k1;
    *(u32x4*)(Kl + (i2 >> 3) * 72 + (i2 & 7) * 8) = R.k2; *(u32x4*)(Kl + (i3 >> 3) * 72 + (i3 & 7) * 8) = R.k3;
    *(u32x4*)(Ul + (tid >> 3) * 72 + (tid & 7) * 8) = R.u0;
  }
#pragma unroll
  for (int gq = 0; gq < 4; ++gq) *(s16x4*)(SbT + r * 136 + 32 * wv + 8 * gq + 4 * hh) = pack4(S[4 * gq], S[4 * gq + 1], S[4 * gq + 2], S[4 * gq + 3]);
  __syncthreads();
  bf16x8 akd[4];
#pragma unroll
  for (int s = 0; s < 4; ++s) akd[s] = *(const bf16x8*)(Kl + (32 * wv + r) * 72 + 16 * s + 8 * hh);
  s16x4 u[4];
  if (wv < 2) {
#pragma unroll
    for (int gq = 0; gq < 4; ++gq) u[gq] = *(const s16x4*)(Ul + r * 72 + 32 * wv + 8 * gq + 4 * hh);
  }
  f32x16 acc = zero16();
#pragma unroll
  for (int s = 0; s < 4; ++s) acc = MFMA32(*(const bf16x8*)(Wl + (32 * (wv & 1) + r) * 136 + 64 * (wv >> 1) + 16 * s + 8 * hh), *(const bf16x8*)(SbT + r * 136 + 64 * (wv >> 1) + 16 * s + 8 * hh), acc);
  if (wv >= 2) {
#pragma unroll
    for (int gq = 0; gq < 4; ++gq) part[((wv & 1) * 4 + gq) * 64 + lane] = make_float4(acc[4 * gq], acc[4 * gq + 1], acc[4 * gq + 2], acc[4 * gq + 3]);
  }
  __syncthreads();
  if (wv < 2) {
#pragma unroll
    for (int gq = 0; gq < 4; ++gq) {
      const float4 pp = part[(wv * 4 + gq) * 64 + lane];
      float v0 = bf2f((bf16_t)u[gq][0]) - (acc[4 * gq] + pp.x), v1 = bf2f((bf16_t)u[gq][1]) - (acc[4 * gq + 1] + pp.y);
      float v2 = bf2f((bf16_t)u[gq][2]) - (acc[4 * gq + 2] + pp.z), v3 = bf2f((bf16_t)u[gq][3]) - (acc[4 * gq + 3] + pp.w);
      *(s16x4*)(vnT + r * 72 + 32 * wv + 8 * gq + 4 * hh) = pack4(v0, v1, v2, v3);
    }
  }
  __syncthreads();
#pragma unroll
  for (int q = 0; q < 16; ++q) S[q] *= R.gl;
#pragma unroll
  for (int s = 0; s < 4; ++s) S = MFMA32(akd[s], *(const bf16x8*)(vnT + r * 72 + 16 * s + 8 * hh), S);
}
DI void dn_l1_item(const Params& p, int item, unsigned char* smem) {
  int tid_o = threadIdx.x; asm volatile("" : "+v"(tid_o)); const int tid = tid_o, lane = tid & 63, wv = tid >> 6, r = lane & 31, hh = lane >> 5;
  const int bh = item & 7, cb = item >> 3;
  f32x16 S = zero16();
  DnSt R0, R1, R2;
  const int c0 = bh * NCH;
  dn_l1_load(p, R0, c0, cb, tid); dn_l1_load(p, R1, c0 + 1, cb, tid); dn_l1_load(p, R2, c0 + 2, cb, tid);
  __syncthreads();
  for (int it = 0; it < DN_NG; ++it) {
    const int n = 3 * it;
    { float* Sn = p.out + O_GLS + ((size_t)(bh * DN_NG + it) * 128) * 128;
#pragma unroll
      for (int q = 0; q < 16; ++q) Sn[(32 * wv + crow(q, hh)) * 128 + cb * 32 + r] = S[q]; }
    dn_l1_step(R0, S, smem, tid, lane, wv, r, hh); __builtin_amdgcn_sched_barrier(0); dn_l1_load(p, R0, c0 + (n + 3 < NCH ? n + 3 : NCH - 1), cb, tid); __builtin_amdgcn_sched_barrier(0);
    dn_l1_step(R1, S, smem, tid, lane, wv, r, hh); __builtin_amdgcn_sched_barrier(0); dn_l1_load(p, R1, c0 + (n + 4 < NCH ? n + 4 : NCH - 1), cb, tid); __builtin_amdgcn_sched_barrier(0);
    dn_l1_step(R2, S, smem, tid, lane, wv, r, hh); __builtin_amdgcn_sched_barrier(0); dn_l1_load(p, R2, c0 + (n + 5 < NCH ? n + 5 : NCH - 1), cb, tid); __builtin_amdgcn_sched_barrier(0);
  }
  float* So = p.out + O_DNP + (size_t)bh * 128 * 128;
#pragma unroll
  for (int q = 0; q < 16; ++q) So[(32 * wv + crow(q, hh)) * 128 + cb * 32 + r] = S[q];
  __syncthreads();
}

DI void gla_prep_item(const Params& p, int ci, unsigned char* smem) {
  int tid_o = threadIdx.x; asm volatile("" : "+v"(tid_o)); const int tid = tid_o, lane = tid & 63, wv = tid >> 6, r = lane & 31, hh = lane >> 5;
  const int n = ci % NCH, bh = ci / NCH, b = bh >> 2, h = bh & 3;
  float* gks = (float*)smem;
  float* bc = gks + 64 * 16;
  float* tot = bc + 64 * 128;
  bf16_t* qds = (bf16_t*)(tot + 128);
  bf16_t* kis = qds + 64 * 136;
  const bf16_t* P = (const bf16_t*)(p.ws + W_P);
  const float* sm1 = (const float*)(p.ws + W_SM1);
  unsigned char* C1 = p.ws + W_C1;
  bf16_t* Cqd = (bf16_t*)(C1 + C1_QD) + (size_t)ci * 8192;
  bf16_t* CkdT = (bf16_t*)(C1 + C1_KDT) + (size_t)ci * 8192;
  bf16_t* Cqk = (bf16_t*)(C1 + C1_QK) + (size_t)ci * 4096;
  float* Cgl = (float*)(p.ws + W_GGL) + (size_t)ci * 128;
  const int t0 = 64 * n - 48;
  __syncthreads();
  { float gq4[4];
#pragma unroll
    for (int u = 0; u < 4; ++u) { const int i = tid + 256 * u; const int t = t0 + (i >> 4); gq4[u] = sm1[(size_t)(b * TP + (t < 0 ? 0 : t)) * 16 + (i & 15)]; }
#pragma unroll
    for (int u = 0; u < 4; ++u) { const int i = tid + 256 * u; const int t = t0 + (i >> 4); gks[i] = t >= 0 ? gq4[u] : 0.f; } }
  __syncthreads();
  {
    const int k = tid & 127, half = tid >> 7;
    float wu[16];
    for (int rr = 0; rr < 16; ++rr) wu[rr] = p.w_gk_up[rr * 512 + h * 128 + k];
    const float bg = p.b_gk[h * 128 + k];
    float cum = 0.f;
    for (int ii = 0; ii < 32; ++ii) {
      const int i = 32 * half + ii, t = t0 + i;
      float la = 0.f;
      if (t >= 0) { float a = bg; for (int rr = 0; rr < 16; ++rr) a += gks[i * 16 + rr] * wu[rr]; la = logsigmoidf_(a) * (1.f / 16.f); }
      cum += la; bc[i * 128 + k] = cum;
    }
    if (half == 0) tot[k] = cum;
  }
  __syncthreads();
  { const int k = tid & 127, half = tid >> 7;
    if (half == 1) { const float tt = tot[k]; for (int ii = 32; ii < 64; ++ii) bc[ii * 128 + k] += tt; } }
  __syncthreads();
  {
    const int kp = (tid & 63) * 2, isub = tid >> 6;
    unsigned qw[16], kw[16];
#pragma unroll
    for (int m = 0; m < 16; ++m) {
      int t = t0 + isub + 4 * m; t = t < 0 ? 0 : t;
      const bf16_t* pp = P + (size_t)(b * TP + t) * NC + h * 128 + kp;
      qw[m] = *(const unsigned*)pp; kw[m] = *(const unsigned*)(pp + 512);
    }
#pragma unroll
    for (int m = 0; m < 16; ++m) {
      const int i = isub + 4 * m; const bool ok = (t0 + i) >= 0;
      const float2 bcv = *(const float2*)(bc + i * 128 + kp);
      const float q0 = ok ? __uint_as_float(qw[m] << 16) * 0.08838834764831845f : 0.f, q1 = ok ? __uint_as_float(qw[m] & 0xffff0000u) * 0.08838834764831845f : 0.f;
      const float k0 = ok ? __uint_as_float(kw[m] << 16) : 0.f, k1 = ok ? __uint_as_float(kw[m] & 0xffff0000u) : 0.f;
      const unsigned qd = (unsigned)f2bf(q0 * expf(bcv.x)) | ((unsigned)f2bf(q1 * expf(bcv.y)) << 16);
      *(unsigned*)(qds + i * 136 + kp) = qd; *(unsigned*)(Cqd + i * 128 + kp) = qd;
      *(unsigned*)(kis + i * 136 + kp) = (unsigned)f2bf(k0 * expf(-bcv.x)) | ((unsigned)f2bf(k1 * expf(-bcv.y)) << 16);
    }
  }
  __syncthreads();
  for (int e = tid; e < 128 * 16; e += 256) {
    const int k = e >> 4, i4 = (e & 15) * 4; const float eg = expf(bc[63 * 128 + k]);
    *(s16x4*)(CkdT + k * 64 + i4) = pack4(bf2f(kis[(i4 + 0) * 136 + k]) * eg, bf2f(kis[(i4 + 1) * 136 + k]) * eg, bf2f(kis[(i4 + 2) * 136 + k]) * eg, bf2f(kis[(i4 + 3) * 136 + k]) * eg);
  }
  if (tid < 128) Cgl[tid] = expf(bc[63 * 128 + tid]);
  {
    const int mi = wv >> 1, nj = wv & 1;
    f32x16 a = zero16();
#pragma unroll
    for (int s = 0; s < 8; ++s) a = MFMA32(*(const bf16x8*)(qds + (32 * mi + r) * 136 + 16 * s + 8 * hh), *(const bf16x8*)(kis + (32 * nj + r) * 136 + 16 * s + 8 * hh), a);
    const int j = 32 * nj + r;
#pragma unroll
    for (int q = 0; q < 16; ++q) { const int i = 32 * mi + crow(q, hh); Cqk[i * 64 + j] = f2bf(i >= j ? a[q] : 0.f); }
  }
  __syncthreads();
}

struct GlRegs { bf16x8 aq[8]; bf16x8 akd[4]; bf16x8 aqk[4]; bf16x8 bv[4]; float4 gl[4]; };
DI void gl_load_a(const Params& p, GlRegs& R, int bh, int n, int cb, int wv, int r, int hh) {
  const int ci = bh * NCH + n;
  unsigned char* C1 = p.ws + W_C1;
  if (wv < 2) {
    const bf16_t* A1 = (const bf16_t*)(C1 + C1_QD) + (size_t)ci * 8192 + (32 * wv + r) * 128 + 8 * hh;
#pragma unroll
    for (int s = 0; s < 8; ++s) R.aq[s] = *(const bf16x8*)(A1 + 16 * s);
    const bf16_t* Aqk = (const bf16_t*)(C1 + C1_QK) + (size_t)ci * 4096 + (32 * wv + r) * 64 + 8 * hh;
#pragma unroll
    for (int s = 0; s < 4; ++s) R.aqk[s] = *(const bf16x8*)(Aqk + 16 * s);
  }
}
DI void gl_load_b(const Params& p, GlRegs& R, int bh, int n, int cb, int wv, int r, int hh) {
  const int ci = bh * NCH + n; const int b = bh >> 2, h = bh & 3;
  unsigned char* C1 = p.ws + W_C1;
  const bf16_t* Akd = (const bf16_t*)(C1 + C1_KDT) + (size_t)ci * 8192 + (32 * wv + r) * 64 + 8 * hh;
#pragma unroll
  for (int s = 0; s < 4; ++s) R.akd[s] = *(const bf16x8*)(Akd + 16 * s);
  const bf16_t* V = (const bf16_t*)(p.ws + W_PT) + (size_t)(h * 256 + cb * 32 + r) * LDT + 128 + b * TP + 64 * n - 48 + 8 * hh;
#pragma unroll
  for (int s = 0; s < 4; ++s) R.bv[s] = *(const bf16x8*)(V + 16 * s);
  const float* G = (const float*)(p.ws + W_GGL) + (size_t)ci * 128 + 32 * wv + 4 * hh;
#pragma unroll
  for (int gq = 0; gq < 4; ++gq) R.gl[gq] = *(const float4*)(G + 8 * gq);
}
DI void gla_scan_item(const Params& p, int item, unsigned char* smem) {
  int tid_o = threadIdx.x; asm volatile("" : "+v"(tid_o)); const int tid = tid_o, lane = tid & 63, wv = tid >> 6, r = lane & 31, hh = lane >> 5;
  const int bh = item & 7, j_ = item >> 3; const int cb = j_ & 7, g = j_ >> 3, b = bh >> 2, h = bh & 3;
  const int n0 = 6 * g, n1 = (n0 + 6 < NCH) ? n0 + 6 : NCH;
  bf16_t* SbT = (bf16_t*)smem;
  bf16_t* M = (bf16_t*)(p.ws + W_M);
  f32x16 S;
  GlRegs R;
  gl_load_a(p, R, bh, n0, cb, wv, r, hh);
  gl_load_b(p, R, bh, n0, cb, wv, r, hh);
  { const float* Sn = (const float*)(p.ws + W_SNG) + ((size_t)(bh * GLA_NG + g) * 128) * 256;
#pragma unroll
    for (int q = 0; q < 16; ++q) S[q] = Sn[(32 * wv + crow(q, hh)) * 256 + cb * 32 + r]; }
  __syncthreads();
  for (int n = n0; n < n1; ++n) {
    const int nn = n + 1 < n1 ? n + 1 : n;
    bf16_t* Sb = SbT + (n & 1) * 32 * 136;
#pragma unroll
    for (int gq = 0; gq < 4; ++gq) *(s16x4*)(Sb + r * 136 + 32 * wv + 8 * gq + 4 * hh) = pack4(S[4 * gq], S[4 * gq + 1], S[4 * gq + 2], S[4 * gq + 3]);
    __syncthreads();
    if (wv < 2) {
      f32x16 acc = zero16();
#pragma unroll
      for (int s = 0; s < 8; ++s) acc = MFMA32(R.aq[s], *(const bf16x8*)(Sb + r * 136 + 16 * s + 8 * hh), acc);
#pragma unroll
      for (int s = 0; s < 4; ++s) acc = MFMA32(R.aqk[s], R.bv[s], acc);
      gl_load_a(p, R, bh, nn, cb, wv, r, hh);
      const int tb = 64 * n - 48 + 32 * wv;
#pragma unroll
      for (int q = 0; q < 16; ++q) {
        const int t = tb + crow(q, hh);
        if (t >= 0) M[(size_t)(b * TP + t) * 1024 + h * 256 + cb * 32 + r] = f2bf(acc[q]);
      }
    }
#pragma unroll
    for (int gq = 0; gq < 4; ++gq) { S[4 * gq] *= R.gl[gq].x; S[4 * gq + 1] *= R.gl[gq].y; S[4 * gq + 2] *= R.gl[gq].z; S[4 * gq + 3] *= R.gl[gq].w; }
#pragma unroll
    for (int s = 0; s < 4; ++s) S = MFMA32(R.akd[s], R.bv[s], S);
    gl_load_b(p, R, bh, nn, cb, wv, r, hh);
  }
  __syncthreads();
}

struct GlL1 { bf16x8 akd[4]; bf16x8 bv[4]; float4 gl[4]; };
DI void gl_l1_load(const Params& p, GlL1& R, int bh, int n, int cb, int wv, int r, int hh) {
  const int ci = bh * NCH + n; const int b = bh >> 2, h = bh & 3;
  unsigned char* C1 = p.ws + W_C1;
  const bf16_t* Akd = (const bf16_t*)(C1 + C1_KDT) + (size_t)ci * 8192 + (32 * wv + r) * 64 + 8 * hh;
#pragma unroll
  for (int s = 0; s < 4; ++s) R.akd[s] = *(const bf16x8*)(Akd + 16 * s);
  const bf16_t* V = (const bf16_t*)(p.ws + W_PT) + (size_t)(h * 256 + cb * 32 + r) * LDT + 128 + b * TP + 64 * n - 48 + 8 * hh;
#pragma unroll
  for (int s = 0; s < 4; ++s) R.bv[s] = *(const bf16x8*)(V + 16 * s);
  const float* G = (const float*)(p.ws + W_GGL) + (size_t)ci * 128 + 32 * wv + 4 * hh;
#pragma unroll
  for (int gq = 0; gq < 4; ++gq) R.gl[gq] = *(const float4*)(G + 8 * gq);
}
DI void gl_l1_step(const GlL1& R, f32x16& S) {
#pragma unroll
  for (int gq = 0; gq < 4; ++gq) { S[4 * gq] *= R.gl[gq].x; S[4 * gq + 1] *= R.gl[gq].y; S[4 * gq + 2] *= R.gl[gq].z; S[4 * gq + 3] *= R.gl[gq].w; }
#pragma unroll
  for (int s = 0; s < 4; ++s) S = MFMA32(R.akd[s], R.bv[s], S);
}
template <int PROBE>
DI void gla_l1_item(const Params& p, int item) {
  int tid_o = threadIdx.x; asm volatile("" : "+v"(tid_o)); const int tid = tid_o, lane = tid & 63, wv = tid >> 6, r = lane & 31, hh = lane >> 5;
  const int bh = item & 7, cb = item >> 3;
  f32x16 S = zero16();
  GlL1 R0, R1, R2;
  gl_l1_load(p, R0, bh, 0, cb, wv, r, hh); gl_l1_load(p, R1, bh, 1, cb, wv, r, hh); gl_l1_load(p, R2, bh, 2, cb, wv, r, hh);
  for (int it = 0; it < 43; ++it) {
    const int n = 3 * it;
    if (PROBE == 0 && (it & 1) == 0) { float* Sn = (float*)(p.ws + W_SNG) + ((size_t)(bh * GLA_NG + (it >> 1)) * 128) * 256;
#pragma unroll
      for (int q = 0; q < 16; ++q) Sn[(32 * wv + crow(q, hh)) * 256 + cb * 32 + r] = S[q]; }
    gl_l1_step(R0, S); __builtin_amdgcn_sched_barrier(0); if (PROBE != 1) gl_l1_load(p, R0, bh, (n + 3 < NCH ? n + 3 : NCH - 1), cb, wv, r, hh); __builtin_amdgcn_sched_barrier(0);
    gl_l1_step(R1, S); __builtin_amdgcn_sched_barrier(0); if (PROBE != 1) gl_l1_load(p, R1, bh, (n + 4 < NCH ? n + 4 : NCH - 1), cb, wv, r, hh); __builtin_amdgcn_sched_barrier(0);
    gl_l1_step(R2, S); __builtin_amdgcn_sched_barrier(0); if (PROBE != 1) gl_l1_load(p, R2, bh, (n + 5 < NCH ? n + 5 : NCH - 1), cb, wv, r, hh); __builtin_amdgcn_sched_barrier(0);
  }
  float* So = PROBE ? (float*)(p.ws + W_SNG) + (size_t)8 * GLA_NG * 128 * 256 + (size_t)bh * 128 * 256 : p.out + O_GLP + (size_t)bh * 128 * 256;
#pragma unroll
  for (int q = 0; q < 16; ++q) So[(32 * wv + crow(q, hh)) * 256 + cb * 32 + r] = S[q];
}

DI void gla_grp_item(const Params& p, int item) {
  int tid_o = threadIdx.x; asm volatile("" : "+v"(tid_o)); const int tid = tid_o, lane = tid & 63, wv = tid >> 6, r = lane & 31, hh = lane >> 5;
  const int bh = item & 7, j_ = item >> 3; const int cb = j_ & 7, g = j_ >> 3;
  const int n0 = 6 * g, n1 = (n0 + 6 < NCH) ? n0 + 6 : NCH;
  f32x16 S = zero16();
  float4 ap[4];
#pragma unroll
  for (int gq = 0; gq < 4; ++gq) ap[gq] = make_float4(1.f, 1.f, 1.f, 1.f);
  GlL1 R0, R1, R2;
  gl_l1_load(p, R0, bh, n0, cb, wv, r, hh); gl_l1_load(p, R1, bh, n0 + 1, cb, wv, r, hh); gl_l1_load(p, R2, bh, n0 + 2, cb, wv, r, hh);
  for (int n = n0; n < n1; n += 3) {
    const int na = n + 3 < n1 ? n + 3 : n1 - 1, nb = n + 4 < n1 ? n + 4 : n1 - 1, nc = n + 5 < n1 ? n + 5 : n1 - 1;
#pragma unroll
    for (int gq = 0; gq < 4; ++gq) { ap[gq].x *= R0.gl[gq].x; ap[gq].y *= R0.gl[gq].y; ap[gq].z *= R0.gl[gq].z; ap[gq].w *= R0.gl[gq].w; }
    gl_l1_step(R0, S); __builtin_amdgcn_sched_barrier(0); gl_l1_load(p, R0, bh, na, cb, wv, r, hh); __builtin_amdgcn_sched_barrier(0);
#pragma unroll
    for (int gq = 0; gq < 4; ++gq) { ap[gq].x *= R1.gl[gq].x; ap[gq].y *= R1.gl[gq].y; ap[gq].z *= R1.gl[gq].z; ap[gq].w *= R1.gl[gq].w; }
    gl_l1_step(R1, S); __builtin_amdgcn_sched_barrier(0); gl_l1_load(p, R1, bh, nb, cb, wv, r, hh); __builtin_amdgcn_sched_barrier(0);
#pragma unroll
    for (int gq = 0; gq < 4; ++gq) { ap[gq].x *= R2.gl[gq].x; ap[gq].y *= R2.gl[gq].y; ap[gq].z *= R2.gl[gq].z; ap[gq].w *= R2.gl[gq].w; }
    gl_l1_step(R2, S); __builtin_amdgcn_sched_barrier(0); gl_l1_load(p, R2, bh, nc, cb, wv, r, hh); __builtin_amdgcn_sched_barrier(0);
  }
  float* Dg = (float*)(p.ws + W_SNG) + ((size_t)(bh * GLA_NG + g) * 128) * 256;
#pragma unroll
  for (int q = 0; q < 16; ++q) Dg[(32 * wv + crow(q, hh)) * 256 + cb * 32 + r] = S[q];
  if (cb == 0 && r == 0) {
    float* Ag = (float*)(p.ws + W_AG) + (size_t)(bh * GLA_NG + g) * 128 + 32 * wv + 4 * hh;
#pragma unroll
    for (int gq = 0; gq < 4; ++gq) *(float4*)(Ag + 8 * gq) = ap[gq];
  }
}
DI void gla_gscan(const Params& p, int idx) {
  const int bh = idx >> 13, k = (idx >> 6) & 127, v4 = idx & 63;
  float* base = (float*)(p.ws + W_SNG) + ((size_t)(bh * GLA_NG) * 128 + k) * 256 + v4 * 4;
  const float* ab = (const float*)(p.ws + W_AG) + (size_t)(bh * GLA_NG) * 128 + k;
  float4 d[GLA_NG]; float a[GLA_NG];
#pragma unroll
  for (int g = 0; g < GLA_NG; ++g) { d[g] = *(const float4*)(base + (size_t)g * 128 * 256); a[g] = ab[g * 128]; }
  float4 S = make_float4(0.f, 0.f, 0.f, 0.f);
#pragma unroll
  for (int g = 0; g < GLA_NG; ++g) {
    *(float4*)(base + (size_t)g * 128 * 256) = S;
    S.x = a[g] * S.x + d[g].x; S.y = a[g] * S.y + d[g].y; S.z = a[g] * S.z + d[g].z; S.w = a[g] * S.w + d[g].w;
  }
  *(float4*)(p.out + O_GLP + ((size_t)bh * 128 + k) * 256 + v4 * 4) = S;
}

DI void gate0_phase(const Params& p) {
  const int lane = threadIdx.x & 63, wv = threadIdx.x >> 6;
  const bf16_t* P = (const bf16_t*)(p.ws + W_P);
  bf16_t* M = (bf16_t*)(p.ws + W_M);
  float gn[8];
#pragma unroll
  for (int e = 0; e < 8; ++e) gn[e] = p.onorm_b[(lane * 8 + e) & 127];
  const int stride = gridDim.x * 4;
  int r = blockIdx.x * 4 + wv;
  bf16x8 ovn, zvn;
  if (r < NROWS) { ovn = *(const bf16x8*)(M + (size_t)r * 1024 + 512 + lane * 8); zvn = __builtin_nontemporal_load((const bf16x8*)(P + (size_t)r * NA + 2816 + lane * 8)); }
  for (; r < NROWS; r += stride) {
    const bf16x8 ov = ovn, zv = zvn;
    const int rn = r + stride;
    if (rn < NROWS) { ovn = *(const bf16x8*)(M + (size_t)rn * 1024 + 512 + lane * 8); zvn = __builtin_nontemporal_load((const bf16x8*)(P + (size_t)rn * NA + 2816 + lane * 8)); }
    float o[8]; float ss = 0.f;
#pragma unroll
    for (int e = 0; e < 8; ++e) { o[e] = bf2f((bf16_t)ov[e]); ss += o[e] * o[e]; }
    for (int m = 1; m < 16; m <<= 1) ss += __shfl_xor(ss, m);
    const float rs = rsqrtf(ss * (1.f / 128.f) + EPS);
    bf16x8 res;
#pragma unroll
    for (int e = 0; e < 8; ++e) res[e] = (short)f2bf(o[e] * rs * gn[e] * siluf_(bf2f((bf16_t)zv[e])));
    __builtin_nontemporal_store(res, (bf16x8*)(M + (size_t)r * 1024 + 512 + lane * 8));
  }
}
DI void gate1_phase(const Params& p) {
  const int lane = threadIdx.x & 63, wv = threadIdx.x >> 6;
  const bf16_t* P = (const bf16_t*)(p.ws + W_P);
  bf16_t* M = (bf16_t*)(p.ws + W_M);
  float gn[16];
#pragma unroll
  for (int e = 0; e < 16; ++e) gn[e] = p.onorm_c[(lane * 16 + e) & 255];
  const int stride = gridDim.x * 4;
  int r = blockIdx.x * 4 + wv;
  bf16x8 o0n, o1n, z0n, z1n;
  if (r < NROWS) { o0n = *(const bf16x8*)(M + (size_t)r * 1024 + lane * 16); o1n = *(const bf16x8*)(M + (size_t)r * 1024 + lane * 16 + 8);
                   z0n = __builtin_nontemporal_load((const bf16x8*)(P + (size_t)r * NC + 2048 + lane * 16)); z1n = __builtin_nontemporal_load((const bf16x8*)(P + (size_t)r * NC + 2048 + lane * 16 + 8)); }
  for (; r < NROWS; r += stride) {
    const bf16x8 o0 = o0n, o1 = o1n, z0 = z0n, z1 = z1n;
    const int rn = r + stride;
    if (rn < NROWS) { o0n = *(const bf16x8*)(M + (size_t)rn * 1024 + lane * 16); o1n = *(const bf16x8*)(M + (size_t)rn * 1024 + lane * 16 + 8);
                      z0n = __builtin_nontemporal_load((const bf16x8*)(P + (size_t)rn * NC + 2048 + lane * 16)); z1n = __builtin_nontemporal_load((const bf16x8*)(P + (size_t)rn * NC + 2048 + lane * 16 + 8)); }
    float o[16]; float ss = 0.f;
#pragma unroll
    for (int e = 0; e < 8; ++e) { o[e] = bf2f((bf16_t)o0[e]); o[8 + e] = bf2f((bf16_t)o1[e]); ss += o[e] * o[e] + o[8 + e] * o[8 + e]; }
    for (int m = 1; m < 16; m <<= 1) ss += __shfl_xor(ss, m);
    const float rs = rsqrtf(ss * (1.f / 256.f) + EPS);
    bf16x8 r0, r1;
#pragma unroll
    for (int e = 0; e < 8; ++e) { r0[e] = (short)f2bf(o[e] * rs * gn[e] * siluf_(bf2f((bf16_t)z0[e]))); r1[e] = (short)f2bf(o[8 + e] * rs * gn[8 + e] * siluf_(bf2f((bf16_t)z1[e]))); }
    __builtin_nontemporal_store(r0, (bf16x8*)(M + (size_t)r * 1024 + lane * 16)); __builtin_nontemporal_store(r1, (bf16x8*)(M + (size_t)r * 1024 + lane * 16 + 8));
  }
}

__global__ void __launch_bounds__(256, 2) fwd_megakernel(Params p) {
  cg::grid_group grid = cg::this_grid();
  __shared__ __attribute__((aligned(16))) unsigned char smem[SMEM_BYTES];
  const int tid = threadIdx.x;
  const int G = gridDim.x, B = blockIdx.x;
  __shared__ uint4 xb_words;
  if (tid == 0) xb_words = make_uint4(0u, 0u, 0u, 0u);
  __syncthreads();
  const XcdBarrier xb = xcd_barrier_post((unsigned*)(p.ws + W_BAR), (volatile LAS unsigned*)&xb_words);
  bf16_t* WtA = (bf16_t*)(p.ws + W_WTA); bf16_t* WoA = (bf16_t*)(p.ws + W_WOA);
  bf16_t* WtC = (bf16_t*)(p.ws + W_WTC); bf16_t* WoC = (bf16_t*)(p.ws + W_WOC);
  bf16_t* P = (bf16_t*)(p.ws + W_P); bf16_t* M = (bf16_t*)(p.ws + W_M); bf16_t* Pt = (bf16_t*)(p.ws + W_PT);
  bf16_t* H0 = (bf16_t*)(p.ws + W_C0); bf16_t* H1 = (bf16_t*)(p.ws + W_C1);

  REP(0) {
  for (int t = B; t < 1088; t += G) {
    if (t < 832) wt_tile(p.w_in_ab, LDA_IN, WtA, t, (float*)smem);
    else wt_tile(p.w_out_ab, 1024, WoA, t - 832, (float*)smem);
  }
  for (int i = B * 256 + tid; i < 128 * 128; i += G * 256) Pt[(size_t)(i >> 7) * LDT + (i & 127)] = 0;
  norm_phase<8, 0>(p, p.norm_ab, p.w_in_ab, LDA_IN, NA, H0, (float*)(p.ws + W_SM0), (float*)smem);
  }
  if (p.coop_flag) grid.sync();
  xcd_barrier(xb);
  REP(1) { gemm_phase<0>(p, H0, WtA, NA / 128, (bf16_t*)smem, B, G);
  xcd_barrier(xb); }
  REP(2) { for (int it = B; it < NCI; it += G) dn_prep_item(p, it, smem); if (DUP == 2) xcd_barrier(xb); }
  for (int i = B * 256 + tid; i < 2 * 128 * 128; i += G * 256) {
    const int b = i >> 14, rr = (i >> 7) & 127, c = i & 127; const size_t row = (size_t)(b * TP + TP - 128 + rr);
    p.out[O_SKP + i] = bf2f(P[row * NA + 512 + c]); p.out[O_SVP + i] = bf2f(P[row * NA + 640 + c]);
  }
  for (int i = B * 256 + tid; i < 2 * 3 * 1536; i += G * 256) {
    const int b = i / 4608, rr = (i / 1536) % 3, c = i % 1536;
    p.out[O_CVP + i] = bf2f(P[(size_t)(b * TP + TP - 3 + rr) * NA + 1280 + c]);
  }
  xcd_barrier(xb);
  if (DUP == 13) { if (B < 32) dn_l1_item(p, B, smem); xcd_barrier(xb); }
  if (DUP == 14) { if (B >= 32) for (int it = B - 32; it < 2 * 65 * 8; it += G - 32) swa_prompt_item(p, it); xcd_barrier(xb); }
  REP(15) {
  if (B < 32) dn_l1_item(p, B, smem);
  else {
    const int W = G - 32, wb = B - 32;
    for (int it = wb; it < 2 * 65 * 8; it += W) swa_prompt_item(p, it);
    for (int it = W - 1 - wb; it < 128; it += W) swa_sample_item(p, it, (float*)smem);
    for (int it = (wb + 200) % W; it < 512; it += W) dn_sample_item(p, it, (float*)smem);
    for (int t = wb; t < 1024; t += W) {
      if (t < 768) wt_tile(p.w_in_c, LDC_IN, WtC, t, (float*)smem);
      else wt_tile(p.w_out_c, 1024, WoC, t - 768, (float*)smem);
    }
  }
  xcd_barrier(xb);
  }
  REP(3) { for (int it = B; it < 32 * DN_NG; it += G) dn_scan_item(p, it, smem);
  xcd_barrier(xb); }
  gate0_phase(p);
  xcd_barrier(xb);
  REP(5) { gemm_phase<1>(p, M, WoA, 8, (bf16_t*)smem, B, G);
  xcd_barrier(xb); }
  for (int i = B * 256 + tid; i < 1024 * 128; i += G * 256) Pt[(size_t)(i >> 7) * LDT + (i & 127)] = 0;
  REP(6) {
  norm_phase<16, 1>(p, p.norm_c, p.w_in_c, LDC_IN, NC, H1, (float*)(p.ws + W_SM1), (float*)smem);
  }
  xcd_barrier(xb);
  gemm_phase<2>(p, H1, WtC, NC / 128, (bf16_t*)smem, B, G);
  xcd_barrier(xb);
  REP(8) { for (int it = B; it < NCI; it += G) gla_prep_item(p, it, smem); if (DUP == 8) xcd_barrier(xb); }
  xcd_barrier(xb);
  for (int it = B; it < 64 * GLA_NG; it += G) gla_grp_item(p, it);
  for (int it = G - 1 - B; it < 1024; it += G) gla_sample_item(p, it, (float*)smem);
  xcd_barrier(xb);
  for (int idx = B * 256 + tid; idx < 8 * 128 * 64; idx += G * 256) gla_gscan(p, idx);
  xcd_barrier(xb);
  REP(9) { for (int it = B; it < 64 * GLA_NG; it += G) gla_scan_item(p, it, smem);
  xcd_barrier(xb); }
  gate1_phase(p);
  xcd_barrier(xb);
  gemm_phase<3>(p, M, WoC, 8, (bf16_t*)smem, B, G);
  xcd_barrier(xb);
  {
    const int lane = tid & 63, wv = tid >> 6;
    float4 gv[4];
#pragma unroll
    for (int i = 0; i < 4; ++i) gv[i] = *(const float4*)(p.final_norm + 4 * lane + 256 * i);
    const int stride = G * 4;
    int r = B * 4 + wv;
    float4 xn[4];
    if (r < NROWS) { const float* yr = yrow(p, r);
#pragma unroll
      for (int i = 0; i < 4; ++i) xn[i] = nt_load4(yr + 4 * lane + 256 * i); }
    for (; r < NROWS; r += stride) {
      float4 xc[4];
#pragma unroll
      for (int i = 0; i < 4; ++i) xc[i] = xn[i];
      const int rn = r + stride;
      if (rn < NROWS) { const float* yn = yrow(p, rn);
#pragma unroll
        for (int i = 0; i < 4; ++i) xn[i] = nt_load4(yn + 4 * lane + 256 * i); }
      if (r < NPR) { const int t = r >= TP ? r - TP : r; if (t < 16) continue; }
      float* yr = yrow(p, r);
      float ss = 0.f;
#pragma unroll
      for (int i = 0; i < 4; ++i) ss += xc[i].x * xc[i].x + xc[i].y * xc[i].y + xc[i].z * xc[i].z + xc[i].w * xc[i].w;
      ss = wsum(ss);
      const float rstd = rsqrtf(ss * (1.f / 1024.f) + EPS);
#pragma unroll
      for (int i = 0; i < 4; ++i) nt_store4(yr + 4 * lane + 256 * i, make_float4(xc[i].x * rstd * gv[i].x, xc[i].y * rstd * gv[i].y, xc[i].z * rstd * gv[i].z, xc[i].w * rstd * gv[i].w));
    }
  }
}

extern "C" void kernel_launch(void* const* d_in, const int* in_sizes, int n_in, void* d_out,
                              int out_size, void* d_ws, size_t ws_size, hipStream_t stream) {
  static int grid_blocks = 0;
  if (!grid_blocks) {
    int dev = 0, cus = 0, per_cu = 0;
    (void)hipGetDevice(&dev);
    (void)hipDeviceGetAttribute(&cus, hipDeviceAttributeMultiprocessorCount, dev);
    (void)hipOccupancyMaxActiveBlocksPerMultiprocessor(&per_cu, fwd_megakernel, 256, 0);
    if (per_cu > 2) per_cu = 2;
    if (per_cu < 1) per_cu = 1;
    grid_blocks = cus * per_cu;
  }
  Params p{};
  const float* const* in = (const float* const*)d_in;
  p.x_prompt = in[0]; p.x_sample = in[1]; p.cache_k = in[2]; p.cache_v = in[3];
  p.st_conv = in[4]; p.st_dn = in[5]; p.st_gla = in[6]; p.meta = in[7];
  p.norm_ab = in[8]; p.w_in_ab = in[9]; p.sink = in[10]; p.conv_b = in[11];
  p.a_log = in[12]; p.dt_bias = in[13]; p.onorm_b = in[14]; p.w_out_ab = in[15];
  p.norm_c = in[16]; p.w_in_c = in[17]; p.w_gk_up = in[18]; p.b_gk = in[19];
  p.onorm_c = in[20]; p.w_out_c = in[21]; p.final_norm = in[22];
  p.out = (float*)d_out; p.ws = (unsigned char*)d_ws;
  (void)hipMemsetAsync((unsigned char*)d_ws + W_BAR, 0, XCD_BAR_WORDS * 4, stream);
  void* args[] = {&p};
  hipError_t e = hipLaunchCooperativeKernel((void*)fwd_megakernel, dim3(grid_blocks), dim3(256), args, 0, stream);
  if (e != hipSuccess) fprintf(stderr, "cooperative launch failed: %s (grid %d)\n", hipGetErrorString(e), grid_blocks);
}
```

```cpp
#include <hip/hip_runtime.h>
#include <hip/hip_cooperative_groups.h>
#include <cstdio>
#include <utility>
namespace cg = cooperative_groups;

typedef unsigned short bf16_t;
typedef __attribute__((ext_vector_type(8))) short bf16x8;
typedef __attribute__((ext_vector_type(4))) short s16x4;
typedef __attribute__((ext_vector_type(16))) float f32x16;
typedef __attribute__((ext_vector_type(4))) unsigned u32x4;
typedef __attribute__((ext_vector_type(4))) float f32x4;
__device__ __forceinline__ float4 nt_load4(const float* p) { const f32x4 v = __builtin_nontemporal_load((const f32x4*)p); return make_float4(v[0], v[1], v[2], v[3]); }
__device__ __forceinline__ void nt_store4(float* p, const float4& a) { f32x4 v; v[0] = a.x; v[1] = a.y; v[2] = a.z; v[3] = a.w; __builtin_nontemporal_store(v, (f32x4*)p); }

#define DI __device__ __forceinline__
#define MFMA32(a, b, c) __builtin_amdgcn_mfma_f32_32x32x16_bf16((a), (b), (c), 0, 0, 0)

constexpr int D = 1024;
constexpr int TP = 8208;
constexpr int NPR = 2 * TP;
constexpr int NROWS = NPR + 128;
constexpr int MP = 16640;
constexpr int NA = 3328;
constexpr int NC = 3072;
constexpr int LDA_IN = 3336;
constexpr int LDC_IN = 3088;
constexpr int LDT = MP + 128;
constexpr int NCH = 129;
constexpr int NCI = 8 * NCH;
constexpr float EPS = 1e-6f;

constexpr size_t O_YP = 0;
constexpr size_t O_YS = O_YP + (size_t)2 * 8192 * 1024;
constexpr size_t O_SKP = O_YS + 128 * 1024;
constexpr size_t O_SVP = O_SKP + 2 * 128 * 128;
constexpr size_t O_CVP = O_SVP + 2 * 128 * 128;
constexpr size_t O_DNP = O_CVP + 2 * 3 * 1536;
constexpr size_t O_GLP = O_DNP + 2 * 4 * 128 * 128;
constexpr size_t O_SKS = O_GLP + 2 * 4 * 128 * 256;
constexpr size_t O_SVS = O_SKS + (size_t)128 * 128 * 128;
constexpr size_t O_CVS = O_SVS + (size_t)128 * 128 * 128;
constexpr size_t O_DNS = O_CVS + (size_t)128 * 3 * 1536;
constexpr size_t O_GLS = O_DNS + (size_t)128 * 4 * 128 * 128;

constexpr size_t al256(size_t x) { return (x + 255) & ~(size_t)255; }
constexpr size_t W_WTA = 0;
constexpr size_t W_WOA = W_WTA + (size_t)NA * 1024 * 2;
constexpr size_t W_WTC = W_WOA + (size_t)1024 * 1024 * 2;
constexpr size_t W_WOC = W_WTC + (size_t)NC * 1024 * 2;
constexpr size_t W_SM0 = W_WOC + (size_t)1024 * 1024 * 2;
constexpr size_t W_SM1 = W_SM0 + (size_t)MP * 8 * 4;
constexpr size_t W_YME = W_SM1 + (size_t)MP * 16 * 4;
constexpr size_t W_DGL = W_YME + (size_t)32 * 1024 * 4;
constexpr size_t W_GGL = al256(W_DGL + (size_t)NCI * 4);
constexpr size_t W_BAR = al256(W_GGL + (size_t)NCI * 128 * 4);
constexpr size_t W_P = al256(W_BAR + 3456 * 4);
constexpr size_t W_M = W_P + (size_t)MP * NA * 2;
constexpr size_t W_X = W_M + (size_t)MP * 1024 * 2;
constexpr size_t W_PT = W_X;
constexpr size_t W_C0 = W_X + (size_t)128 * LDT * 2;
constexpr size_t W_C1 = W_X + (size_t)1024 * LDT * 2;
constexpr size_t C0_W = 0;
constexpr size_t C0_UT = C0_W + (size_t)NCI * 8192 * 2;
constexpr size_t C0_QD = C0_UT + (size_t)NCI * 8192 * 2;
constexpr size_t C0_KDT = C0_QD + (size_t)NCI * 8192 * 2;
constexpr size_t C0_QK = C0_KDT + (size_t)NCI * 8192 * 2;
constexpr size_t W_SNG = al256(W_C1 + (size_t)NCI * 40960);
constexpr size_t W_AG = W_SNG + (size_t)8 * 22 * 128 * 256 * 4;
constexpr int DN_NG = 43, GLA_NG = 22;
constexpr size_t C1_QD = 0;
constexpr size_t C1_KDT = C1_QD + (size_t)NCI * 8192 * 2;
constexpr size_t C1_QK = C1_KDT + (size_t)NCI * 8192 * 2;

constexpr int SMEM_BYTES = 74752;
#ifndef DUP
#define DUP -1
#endif
#define REP(k) for (int rep_ = 0; rep_ < (DUP == (k) ? 2 : 1); ++rep_)

struct Params {
  const float* x_prompt; const float* x_sample; const float* cache_k; const float* cache_v;
  const float* st_conv; const float* st_dn; const float* st_gla; const float* meta;
  const float* norm_ab; const float* w_in_ab; const float* sink; const float* conv_b;
  const float* a_log; const float* dt_bias; const float* onorm_b; const float* w_out_ab;
  const float* norm_c; const float* w_in_c; const float* w_gk_up; const float* b_gk;
  const float* onorm_c; const float* w_out_c; const float* final_norm;
  float* out; unsigned char* ws;
  int coop_flag; int pad_;
};

DI bf16_t f2bf(float x) { unsigned u = __float_as_uint(x); u += 0x7fffu + ((u >> 16) & 1u); return (bf16_t)(u >> 16); }
DI float bf2f(bf16_t s) { return __uint_as_float(((unsigned)s) << 16); }
DI s16x4 pack4(float a, float b, float c, float d) { s16x4 v; v[0] = (short)f2bf(a); v[1] = (short)f2bf(b); v[2] = (short)f2bf(c); v[3] = (short)f2bf(d); return v; }
DI int crow(int reg, int h) { return (reg & 3) + 8 * (reg >> 2) + 4 * h; }
DI float wsum(float v) { for (int o = 32; o > 0; o >>= 1) v += __shfl_xor(v, o); return v; }
DI float sigmoidf_(float x) { return 1.f / (1.f + __expf(-x)); }
DI float siluf_(float x) { return x / (1.f + __expf(-x)); }
DI float softplusf_(float x) { return x > 20.f ? x : log1pf(expf(x)); }
DI float logsigmoidf_(float x) { return fminf(x, 0.f) - log1pf(expf(-fabsf(x))); }
DI f32x16 zero16() { f32x16 z; for (int i = 0; i < 16; ++i) z[i] = 0.f; return z; }

DI const float* xrow_v(const float* xs, const float* xm, const float* xp, int r) {
  const bool smp = r >= NPR;
  const int b = (!smp && r >= TP) ? 1 : 0;
  const int t = r - b * TP;
  const bool met = !smp && t < 16;
  const float* base = smp ? xs : (met ? xm : xp);
  const int off = smp ? (r - NPR) : (met ? t : (b * 8192 + t - 16));
  return base + (size_t)off * D;
}
DI float* yrow_v(float* ys, float* ym, float* yp, int r) {
  const bool smp = r >= NPR;
  const int b = (!smp && r >= TP) ? 1 : 0;
  const int t = r - b * TP;
  const bool met = !smp && t < 16;
  float* base = smp ? ys : (met ? ym : yp);
  const int off = smp ? (r - NPR) : (met ? (b * 16 + t) : (b * 8192 + t - 16));
  return base + (size_t)off * D;
}
DI const float* xrow(const Params& p, int r) { const float* xs = p.x_sample; const float* xm = p.meta; const float* xp = p.x_prompt; return xrow_v(xs, xm, xp, r); }
DI float* yrow(const Params& p, int r) { float* o = p.out; unsigned char* w = p.ws; return yrow_v(o + O_YS, (float*)(w + W_YME), o + O_YP, r); }

#define XB_TMO      128
#define XB_XCNT(j)  (256  + 64 * (j))
#define XB_XSUB(j)  (1280 + 64 * (j))
#define XB_XGEN(j)  (2304 + 64 * (j))
#define XB_TOP      3328
#define XB_TOPGEN   3392
#define XCD_BAR_WORDS 3456
#define XB_SPIN_CAP (1u << 20)
#define LAS __attribute__((address_space(3)))
DI unsigned xb_ld(unsigned* p)              { return __hip_atomic_load(p, __ATOMIC_RELAXED, __HIP_MEMORY_SCOPE_AGENT); }
DI unsigned xb_add(unsigned* p, unsigned v) { return __hip_atomic_fetch_add(p, v, __ATOMIC_RELAXED, __HIP_MEMORY_SCOPE_AGENT); }
DI unsigned xb_xcc_id() { return (unsigned)__builtin_amdgcn_s_getreg((3 << 11) | 20) & 0xFu; }
#define XB_SPIN(cond, bar) do { unsigned _sp = 0; while (cond) { __builtin_amdgcn_s_sleep(3); \
    if ((++_sp & 255u) == 0u) { if (xb_ld(&(bar)[XB_TMO])) break; if (_sp > XB_SPIN_CAP) { atomicAdd(&(bar)[XB_TMO], 1u); break; } } } } while (0)
struct XcdBarrier { unsigned* bar; unsigned x; volatile LAS unsigned* st; };
DI XcdBarrier xcd_barrier_post(unsigned* bar, volatile LAS unsigned* st) {
  XcdBarrier b; b.bar = bar; b.x = xb_xcc_id(); b.st = st;
  if (threadIdx.x == 0) (void)xb_add(&bar[XB_XCNT(b.x)], 1u);
  return b;
}
DI void xcd_barrier_complete(unsigned* bar, unsigned x, unsigned& nloc, unsigned& nx) {
  const unsigned G = gridDim.x * gridDim.y * gridDim.z;
  unsigned sum, cnt, mine, sp = 0u;
  for (;;) {
    sum = 0u; cnt = 0u; mine = 0u;
#pragma unroll
    for (unsigned j = 0; j < 16; ++j) { const unsigned c = xb_ld(&bar[XB_XCNT(j)]); sum += c; cnt += (c > 0u) ? 1u : 0u; mine = (j == x) ? c : mine; }
    if (sum == G) break;
    __builtin_amdgcn_s_sleep(1);
    if ((++sp & 255u) == 0u) { if (xb_ld(&bar[XB_TMO])) break; if (sp > XB_SPIN_CAP) { atomicAdd(&bar[XB_TMO], 1u); break; } }
  }
  nloc = mine > 0u ? mine : 1u; nx = cnt > 0u ? cnt : 1u;
}
DI void xcd_barrier(const XcdBarrier& b) {
  asm volatile("s_waitcnt vmcnt(0)" ::: "memory");
  __syncthreads();
  if (threadIdx.x < 64 && b.st[0] == 0u) {
    const unsigned ln = threadIdx.x;
    const unsigned Gt = gridDim.x * gridDim.y * gridDim.z;
    unsigned c = 0u, sum = 0u, cnt = 0u, mine = 0u, sp = 0u;
    for (;;) {
      c = ln < 16u ? xb_ld(&b.bar[XB_XCNT(ln)]) : 0u;
      sum = c; cnt = c > 0u ? 1u : 0u; mine = (ln == b.x) ? c : 0u;
      for (int o = 32; o > 0; o >>= 1) { sum += __shfl_xor(sum, o); cnt += __shfl_xor(cnt, o); mine += __shfl_xor(mine, o); }
      if (sum == Gt || ++sp > XB_SPIN_CAP) break;
      __builtin_amdgcn_s_sleep(1);
    }
    if (ln == 0u) { b.st[1] = cnt > 0u ? cnt : 1u; b.st[0] = mine > 0u ? mine : 1u; }
  }
  if (threadIdx.x == 0) {
    unsigned* bar = b.bar;
    __builtin_amdgcn_s_waitcnt(0);
    unsigned nloc = b.st[0], nx = b.st[1];
    if (nloc == 0u) { xcd_barrier_complete(bar, b.x, nloc, nx); b.st[0] = nloc; b.st[1] = nx; }
    const unsigned old = xb_add(&bar[XB_XSUB(b.x)], 1u);
    const unsigned gen = old / nloc;
    if (old + 1u == (gen + 1u) * nloc) {
      __builtin_amdgcn_fence(__ATOMIC_RELEASE, "agent");
      asm volatile("s_waitcnt vmcnt(0)" ::: "memory");
      const unsigned og = xb_add(&bar[XB_TOP], 1u);
      const unsigned tg = og / nx;
      if (og + 1u == (tg + 1u) * nx) xb_add(&bar[XB_TOPGEN], 1u);
      else XB_SPIN(xb_ld(&bar[XB_TOPGEN]) == tg, bar);
      __builtin_amdgcn_fence(__ATOMIC_ACQUIRE, "agent");
      xb_add(&bar[XB_XGEN(b.x)], 1u);
      asm volatile("s_waitcnt vmcnt(0)" ::: "memory");
    } else {
      XB_SPIN(xb_ld(&bar[XB_XGEN(b.x)]) == gen, bar);
      __builtin_amdgcn_fence(__ATOMIC_ACQUIRE, "agent");
      asm volatile("s_waitcnt vmcnt(0)" ::: "memory");
    }
  }
  __syncthreads();
}

DI void wt_tile(const float* src, int ld, bf16_t* dst, int tile, float* tl) {
  int tid_o = threadIdx.x; asm volatile("" : "+v"(tid_o)); const int tid = tid_o;
  const int k0 = (tile & 15) * 64, n0 = (tile >> 4) * 64;
  float tv[16];
#pragma unroll
  for (int i = 0; i < 16; ++i) { const int idx = tid + 256 * i; const int kk = idx >> 6, nn = idx & 63; tv[i] = __builtin_nontemporal_load(src + (size_t)(k0 + kk) * ld + n0 + nn); }
#pragma unroll
  for (int i = 0; i < 16; ++i) { const int idx = tid + 256 * i; const int kk = idx >> 6, nn = idx & 63; tl[kk * 65 + nn] = tv[i]; }
  __syncthreads();
#pragma unroll
  for (int i = 0; i < 16; ++i) { const int idx = tid + 256 * i; const int nn = idx >> 6, kk = idx & 63; dst[(size_t)(n0 + nn) * 1024 + k0 + kk] = f2bf(tl[kk * 65 + nn]); }
  __syncthreads();
}

template <int NS, int LAYER>
DI void norm_phase(const Params& p, const float* g, const float* wsm, int ldw, int ncol0, bf16_t* hb, float* small, float* Ws) {
  int tid_o = threadIdx.x; asm volatile("" : "+v"(tid_o)); const int tid = tid_o, lane = tid & 63, wv = tid >> 6;
  __syncthreads();
  for (int i0 = tid; i0 < 1024 * NS; i0 += 256 * 8) {
    float wv8[8];
#pragma unroll
    for (int u = 0; u < 8; ++u) { const int i = i0 + 256 * u; wv8[u] = wsm[(size_t)(i / NS) * ldw + ncol0 + (i % NS)]; }
#pragma unroll
    for (int u = 0; u < 8; ++u) { const int i = i0 + 256 * u; Ws[(i % NS) * 1024 + (i / NS)] = wv8[u]; }
  }
  __syncthreads();
  float4 gv[4];
#pragma unroll
  for (int i = 0; i < 4; ++i) gv[i] = *(const float4*)(g + 4 * lane + 256 * i);
  const int stride = gridDim.x * 4;
  int r = blockIdx.x * 4 + wv;
  float4 xn[4];
  if (r < NROWS) { const float* xr = LAYER == 0 ? xrow(p, r) : (const float*)yrow(p, r);
#pragma unroll
    for (int i = 0; i < 4; ++i) xn[i] = nt_load4(xr + 4 * lane + 256 * i); }
  for (; r < MP; r += stride) {
    float4 xc[4];
#pragma unroll
    for (int i = 0; i < 4; ++i) xc[i] = xn[i];
    const int rn = r + stride;
    if (rn < NROWS) { const float* xr = LAYER == 0 ? xrow(p, rn) : (const float*)yrow(p, rn);
#pragma unroll
      for (int i = 0; i < 4; ++i) xn[i] = nt_load4(xr + 4 * lane + 256 * i); }
    if (r >= NROWS) {
#pragma unroll
      for (int i = 0; i < 4; ++i) *(s16x4*)(hb + (size_t)r * D + 4 * lane + 256 * i) = pack4(0.f, 0.f, 0.f, 0.f);
      if (lane < NS) small[(size_t)r * NS + lane] = 0.f;
      continue;
    }
    float ss = 0.f;
#pragma unroll
    for (int i = 0; i < 4; ++i) ss += xc[i].x * xc[i].x + xc[i].y * xc[i].y + xc[i].z * xc[i].z + xc[i].w * xc[i].w;
    ss = wsum(ss);
    const float rstd = rsqrtf(ss * (1.f / 1024.f) + EPS);
    float acc[NS];
#pragma unroll
    for (int c = 0; c < NS; ++c) acc[c] = 0.f;
#pragma unroll
    for (int i = 0; i < 4; ++i) {
      const float h0 = xc[i].x * rstd * gv[i].x, h1 = xc[i].y * rstd * gv[i].y, h2 = xc[i].z * rstd * gv[i].z, h3 = xc[i].w * rstd * gv[i].w;
      *(s16x4*)(hb + (size_t)r * D + 4 * lane + 256 * i) = pack4(h0, h1, h2, h3);
#pragma unroll
      for (int c = 0; c < NS; ++c) { const float4 w4 = *(const float4*)(Ws + c * 1024 + 4 * lane + 256 * i); acc[c] += h0 * w4.x + h1 * w4.y + h2 * w4.z + h3 * w4.w; }
    }
#pragma unroll
    for (int c = 0; c < NS; ++c) acc[c] = wsum(acc[c]);
    if (lane == 0) { float4* so = (float4*)(small + (size_t)r * NS);
#pragma unroll
      for (int c4 = 0; c4 < NS / 4; ++c4) so[c4] = make_float4(acc[c4 * 4], acc[c4 * 4 + 1], acc[c4 * 4 + 2], acc[c4 * 4 + 3]); }
  }
  __syncthreads();
}

struct G8 { uint4 a0, a1, a2, a3, b0, b1, b2, b3; };
DI void gemm_gload(G8& g, const bf16_t* Ag, const bf16_t* Bg, int kt) {
  g.a0 = *(const uint4*)(Ag + kt * 64); g.a1 = *(const uint4*)(Ag + (size_t)32 * 1024 + kt * 64); g.a2 = *(const uint4*)(Ag + (size_t)64 * 1024 + kt * 64); g.a3 = *(const uint4*)(Ag + (size_t)96 * 1024 + kt * 64);
  g.b0 = *(const uint4*)(Bg + kt * 64); g.b1 = *(const uint4*)(Bg + (size_t)32 * 1024 + kt * 64); g.b2 = *(const uint4*)(Bg + (size_t)64 * 1024 + kt * 64); g.b3 = *(const uint4*)(Bg + (size_t)96 * 1024 + kt * 64);
}
DI void gemm_swrite(const G8& g, bf16_t* Asw, bf16_t* Bsw, int buf) {
  bf16_t* a = Asw + buf * 128 * 72; bf16_t* b = Bsw + buf * 128 * 72;
  *(uint4*)(a) = g.a0; *(uint4*)(a + 32 * 72) = g.a1; *(uint4*)(a + 64 * 72) = g.a2; *(uint4*)(a + 96 * 72) = g.a3;
  *(uint4*)(b) = g.b0; *(uint4*)(b + 32 * 72) = g.b1; *(uint4*)(b + 64 * 72) = g.b2; *(uint4*)(b + 96 * 72) = g.b3;
}
DI void gemm_comp(f32x16& c00, f32x16& c01, f32x16& c10, f32x16& c11, const bf16_t* Ab, const bf16_t* Bb, int co0, int co1, int co2, int co3) {
#define GK(CO) { bf16x8 a0 = *(const bf16x8*)(Ab + (CO)), a1 = *(const bf16x8*)(Ab + 32 * 64 + (CO)); bf16x8 b0 = *(const bf16x8*)(Bb + (CO)), b1 = *(const bf16x8*)(Bb + 32 * 64 + (CO)); \
    c00 = MFMA32(a0, b0, c00); c01 = MFMA32(a0, b1, c01); c10 = MFMA32(a1, b0, c10); c11 = MFMA32(a1, b1, c11); }
  GK(co0) GK(co1) GK(co2) GK(co3)
#undef GK
}
template <int EPI>
DI void gemm_tile(const Params& p, const bf16_t* __restrict__ A, const bf16_t* __restrict__ Bt, int m0, int n0, bf16_t* sm) {
  int tid_o = threadIdx.x; asm volatile("" : "+v"(tid_o)); const int tid = tid_o, lane = tid & 63, wv = tid >> 6, r = lane & 31, hh = lane >> 5;
  const int wm = wv >> 1, wn = wv & 1;
  bf16_t* As = sm;
  bf16_t* Bs = sm + 2 * 128 * 64;
  f32x16 c00 = zero16(), c01 = zero16(), c10 = zero16(), c11 = zero16();
  const int lrow = tid >> 3, lkc = (tid & 7) * 8;
  const bf16_t* Ag = A + (size_t)(m0 + lrow) * 1024 + lkc;
  const bf16_t* Bg = Bt + (size_t)(n0 + lrow) * 1024 + lkc;
  const int ch = tid & 7, swz = (lrow >> 1) & 7;
  bf16_t* Asw = As + lrow * 64 + ((ch ^ swz) << 3); bf16_t* Bsw = Bs + lrow * 64 + ((ch ^ swz) << 3);
  const int rk = (r >> 1) & 7;
  const bf16_t* Abase = As + (wm * 64 + r) * 64; const bf16_t* Bbase = Bs + (wn * 64 + r) * 64;
  const int co0 = ((0 + hh) ^ rk) << 3, co1 = ((2 + hh) ^ rk) << 3, co2 = ((4 + hh) ^ rk) << 3, co3 = ((6 + hh) ^ rk) << 3;
  uint4 pa0, pa1, pa2, pa3, pb0, pb1, pb2, pb3, qa0, qa1, qa2, qa3, qb0, qb1, qb2, qb3;
#define GLD(X, KT) X##a0 = *(const uint4*)(Ag + (KT) * 64); X##a1 = *(const uint4*)(Ag + 32 * 1024 + (KT) * 64); X##a2 = *(const uint4*)(Ag + 64 * 1024 + (KT) * 64); X##a3 = *(const uint4*)(Ag + 96 * 1024 + (KT) * 64); \
                   X##b0 = *(const uint4*)(Bg + (KT) * 64); X##b1 = *(const uint4*)(Bg + 32 * 1024 + (KT) * 64); X##b2 = *(const uint4*)(Bg + 64 * 1024 + (KT) * 64); X##b3 = *(const uint4*)(Bg + 96 * 1024 + (KT) * 64);
#define SWR(X, BUF) *(uint4*)(Asw + (BUF) * 8192) = X##a0; *(uint4*)(Asw + (BUF) * 8192 + 32 * 64) = X##a1; *(uint4*)(Asw + (BUF) * 8192 + 64 * 64) = X##a2; *(uint4*)(Asw + (BUF) * 8192 + 96 * 64) = X##a3; \
                    *(uint4*)(Bsw + (BUF) * 8192) = X##b0; *(uint4*)(Bsw + (BUF) * 8192 + 32 * 64) = X##b1; *(uint4*)(Bsw + (BUF) * 8192 + 64 * 64) = X##b2; *(uint4*)(Bsw + (BUF) * 8192 + 96 * 64) = X##b3;
  GLD(p, 0) GLD(q, 1)
  SWR(p, 0) __syncthreads();
  for (int kt = 0; kt < 16; kt += 2) {
    if (kt + 2 < 16) { GLD(p, kt + 2) }
    __builtin_amdgcn_sched_barrier(0);
    gemm_comp(c00, c01, c10, c11, Abase, Bbase, co0, co1, co2, co3);
    SWR(q, 1)
    __syncthreads();
    if (kt + 3 < 16) { GLD(q, kt + 3) }
    __builtin_amdgcn_sched_barrier(0);
    gemm_comp(c00, c01, c10, c11, Abase + 8192, Bbase + 8192, co0, co1, co2, co3);
    if (kt + 2 < 16) { SWR(p, 0) }
    __syncthreads();
  }
#undef GLD
#undef SWR
  f32x16 acc[2][2]; acc[0][0] = c00; acc[0][1] = c01; acc[1][0] = c10; acc[1][1] = c11;
  const float* xbs = p.x_sample; const float* xbm = p.meta; const float* xbp = p.x_prompt;
  float* ybs = p.out + O_YS; float* ybm = (float*)(p.ws + W_YME); float* ybp = p.out + O_YP;
  bf16_t* P = (bf16_t*)(p.ws + W_P);
  bf16_t* Pt = (bf16_t*)(p.ws + W_PT);
#pragma unroll
  for (int i = 0; i < 2; ++i)
#pragma unroll
    for (int j = 0; j < 2; ++j) {
      const int n = n0 + wn * 64 + 32 * j + r;
      const int mb = m0 + wm * 64 + 32 * i;
      if (EPI == 0 || EPI == 2) {
        const int ldp = EPI == 0 ? NA : NC;
#pragma unroll
        for (int q = 0; q < 16; ++q) P[(size_t)(mb + crow(q, hh)) * ldp + n] = f2bf(acc[i][j][q]);
        const int tlo = EPI == 0 ? 640 : 1024, thi = EPI == 0 ? 768 : 2048;
        if (n >= tlo && n < thi) {
#pragma unroll
          for (int gq = 0; gq < 4; ++gq)
            *(s16x4*)(Pt + (size_t)(n - tlo) * LDT + 128 + mb + 8 * gq + 4 * hh) = pack4(acc[i][j][4 * gq], acc[i][j][4 * gq + 1], acc[i][j][4 * gq + 2], acc[i][j][4 * gq + 3]);
        }
      } else {
        float* yp[16]; float rv[16];
#pragma unroll
        for (int q = 0; q < 16; ++q) {
          const int m = mb + crow(q, hh);
          const int mc = m < NROWS ? m : NROWS - 1;
          yp[q] = yrow_v(ybs, ybm, ybp, mc) + n;
          rv[q] = EPI == 1 ? __builtin_nontemporal_load(xrow_v(xbs, xbm, xbp, mc) + n) : __builtin_nontemporal_load(yp[q]);
        }
#pragma unroll
        for (int q = 0; q < 16; ++q) {
          const int m = mb + crow(q, hh);
          if (m < NROWS) __builtin_nontemporal_store(rv[q] + acc[i][j][q], yp[q]);
        }
      }
    }
}

template <int EPI>
DI void gemm_phase(const Params& p, const bf16_t* A, const bf16_t* Bt, int NT, bf16_t* sm, int wg0, int nwg) {
  constexpr int MT = MP / 128;
  const int x = wg0 & 7, w = wg0 >> 3, nw = nwg >> 3;
  const int mlo = (x * MT) >> 3, mhi = ((x + 1) * MT) >> 3, Mx = mhi - mlo;
  const int full = NT >> 3, rem = NT & 7, Tx = Mx * NT, fullT = full * 8 * Mx;
  for (int j = w; j < Tx; j += nw) {
    int mi, nt;
    if (j < fullT) { const int ng = j / (8 * Mx), jj = j - ng * 8 * Mx; mi = jj >> 3; nt = ng * 8 + (jj & 7); }
    else { const int jj = j - fullT; mi = jj / rem; nt = full * 8 + (jj - mi * rem); }
    gemm_tile<EPI>(p, A, Bt, (mlo + mi) * 128, nt * 128, sm);
  }
}

DI void swa_prompt_item(const Params& p, int item) {
  int tid_o = threadIdx.x; asm volatile("" : "+v"(tid_o)); const int tid = tid_o, lane = tid & 63, wv = tid >> 6, r = lane & 31, hh = lane >> 5;
  const int hd = item & 7; const int qb = (item >> 3) % 65; const int b = item / (8 * 65);
  const int kvh = hd >> 2;
  const bf16_t* P = (const bf16_t*)(p.ws + W_P);
  const bf16_t* Pt = (const bf16_t*)(p.ws + W_PT);
  bf16_t* M = (bf16_t*)(p.ws + W_M);
  const int tq = qb * 128 + wv * 32 + r;
  const int tqc = tq < TP ? tq : TP - 1;
  const int kb0 = qb * 128 - 128 + 32 * wv;
  bf16x8 qf[4];
  { const bf16_t* qp = P + (size_t)(b * TP + tqc) * NA + hd * 64 + 8 * hh;
    for (int ks = 0; ks < 4; ++ks) qf[ks] = *(const bf16x8*)(qp + 16 * ks); }
  f32x16 st[5];
#pragma unroll
  for (int j = 0; j < 5; ++j) {
    int kp = kb0 + 32 * j + r; kp = kp < 0 ? 0 : (kp > TP - 1 ? TP - 1 : kp);
    const bf16_t* kptr = P + (size_t)(b * TP + kp) * NA + 512 + kvh * 64 + 8 * hh;
    f32x16 a = zero16();
#pragma unroll
    for (int ks = 0; ks < 4; ++ks) { bf16x8 kf = *(const bf16x8*)(kptr + 16 * ks); a = MFMA32(kf, qf[ks], a); }
    st[j] = a;
  }
  const float sk = p.sink[hd];
  float mx = -1e30f;
#pragma unroll
  for (int j = 0; j < 5; ++j)
#pragma unroll
    for (int q = 0; q < 16; ++q) {
      int kp = kb0 + 32 * j + crow(q, hh); int df = tq - kp;
      bool ok = (kp >= 0) && (df >= 0) && (df < 128);
      float s = ok ? st[j][q] * 0.125f : -1e30f;
      st[j][q] = s; mx = fmaxf(mx, s);
    }
  mx = fmaxf(mx, __shfl_xor(mx, 32));
  mx = fmaxf(mx, sk);
  float sum = 0.f;
#pragma unroll
  for (int j = 0; j < 5; ++j)
#pragma unroll
    for (int q = 0; q < 16; ++q) { float s = st[j][q]; float e = s > -1e29f ? __expf(s - mx) : 0.f; st[j][q] = e; sum += e; }
  sum += __shfl_xor(sum, 32);
  const float inv = 1.f / (sum + __expf(sk - mx));
  f32x16 ot[2]; ot[0] = zero16(); ot[1] = zero16();
#pragma unroll
  for (int j = 0; j < 5; ++j)
#pragma unroll
    for (int s = 0; s < 2; ++s) {
      bf16x8 pf;
#pragma unroll
      for (int e = 0; e < 8; ++e) pf[e] = (short)f2bf(st[j][8 * s + e]);
      const int kidx = 128 + b * TP + kb0 + 32 * j + 16 * s + 4 * hh;
#pragma unroll
      for (int dt = 0; dt < 2; ++dt) {
        const bf16_t* vp = Pt + (size_t)(kvh * 64 + dt * 32 + r) * LDT + kidx;
        s16x4 lo = *(const s16x4*)(vp), hi = *(const s16x4*)(vp + 8);
        bf16x8 vf = __builtin_shufflevector(lo, hi, 0, 1, 2, 3, 4, 5, 6, 7);
        ot[dt] = MFMA32(vf, pf, ot[dt]);
      }
    }
  if (tq < TP) {
    const size_t row = (size_t)(b * TP + tq);
#pragma unroll
    for (int dt = 0; dt < 2; ++dt)
#pragma unroll
      for (int gq = 0; gq < 4; ++gq) {
        const int d = dt * 32 + 8 * gq + 4 * hh;
        s16x4 z4 = *(const s16x4*)(P + row * NA + 768 + hd * 64 + d);
        float o0 = ot[dt][4 * gq] * inv * siluf_(bf2f((bf16_t)z4[0]));
        float o1 = ot[dt][4 * gq + 1] * inv * siluf_(bf2f((bf16_t)z4[1]));
        float o2 = ot[dt][4 * gq + 2] * inv * siluf_(bf2f((bf16_t)z4[2]));
        float o3 = ot[dt][4 * gq + 3] * inv * siluf_(bf2f((bf16_t)z4[3]));
        *(s16x4*)(M + row * 1024 + hd * 64 + d) = pack4(o0, o1, o2, o3);
      }
  }
}

DI void swa_sample_item(const Params& p, int b, float* smf) {
  int tid_o = threadIdx.x; asm volatile("" : "+v"(tid_o)); const int tid = tid_o, lane = tid & 63, wv = tid >> 6;
  float* kbuf = smf;
  float* sc = smf + 128 * 129;
  float* qsh = sc + 8 * 128;
  const bf16_t* P = (const bf16_t*)(p.ws + W_P);
  bf16_t* M = (bf16_t*)(p.ws + W_M);
  const size_t row = (size_t)(NPR + b);
  const bf16_t* pr = P + row * NA;
  __syncthreads();
  for (int i = tid; i < 512; i += 256) qsh[i] = bf2f(pr[i]);
  {
    const float4* src = (const float4*)(p.cache_k + (size_t)b * 16384 + 128);
    float4* dst = (float4*)(p.out + O_SKS + (size_t)b * 16384);
    float4 cv[16];
#pragma unroll
    for (int j = 0; j < 16; ++j) { const int i4 = tid + 256 * j; cv[j] = nt_load4((const float*)(src + (i4 < 127 * 32 ? i4 : 0))); }
#pragma unroll
    for (int j = 0; j < 16; ++j) { const int i4 = tid + 256 * j; if (i4 < 127 * 32) { const float4 v = cv[j]; nt_store4((float*)(dst + i4), v); float* kb = kbuf + (i4 >> 5) * 129 + (i4 & 31) * 4; kb[0] = v.x; kb[1] = v.y; kb[2] = v.z; kb[3] = v.w; } }
    if (tid < 128) { const float v = bf2f(pr[512 + tid]); p.out[O_SKS + (size_t)b * 16384 + 127 * 128 + tid] = v; kbuf[127 * 129 + tid] = v; }
  }
  __syncthreads();
  { const int kk = tid & 127, kvh = tid >> 7;
    float d0 = 0.f, d1 = 0.f, d2 = 0.f, d3 = 0.f;
    for (int d = 0; d < 64; ++d) { float kv = kbuf[kk * 129 + kvh * 64 + d]; const float* qq = qsh + kvh * 256 + d; d0 += qq[0] * kv; d1 += qq[64] * kv; d2 += qq[128] * kv; d3 += qq[192] * kv; }
    sc[(kvh * 4 + 0) * 128 + kk] = d0 * 0.125f; sc[(kvh * 4 + 1) * 128 + kk] = d1 * 0.125f; sc[(kvh * 4 + 2) * 128 + kk] = d2 * 0.125f; sc[(kvh * 4 + 3) * 128 + kk] = d3 * 0.125f; }
  __syncthreads();
  for (int hq = 0; hq < 2; ++hq) {
    const int h = wv * 2 + hq; const float sk = p.sink[h];
    float s0 = sc[h * 128 + lane], s1 = sc[h * 128 + lane + 64];
    float m = fmaxf(s0, s1); for (int o = 32; o > 0; o >>= 1) m = fmaxf(m, __shfl_xor(m, o)); m = fmaxf(m, sk);
    float e0 = __expf(s0 - m), e1 = __expf(s1 - m); float sum = wsum(e0 + e1);
    float inv = 1.f / (sum + __expf(sk - m));
    sc[h * 128 + lane] = e0 * inv; sc[h * 128 + lane + 64] = e1 * inv;
  }
  __syncthreads();
  {
    const float4* src = (const float4*)(p.cache_v + (size_t)b * 16384 + 128);
    float4* dst = (float4*)(p.out + O_SVS + (size_t)b * 16384);
    float4 cv[16];
#pragma unroll
    for (int j = 0; j < 16; ++j) { const int i4 = tid + 256 * j; cv[j] = nt_load4((const float*)(src + (i4 < 127 * 32 ? i4 : 0))); }
#pragma unroll
    for (int j = 0; j < 16; ++j) { const int i4 = tid + 256 * j; if (i4 < 127 * 32) { const float4 v = cv[j]; nt_store4((float*)(dst + i4), v); float* kb = kbuf + (i4 >> 5) * 129 + (i4 & 31) * 4; kb[0] = v.x; kb[1] = v.y; kb[2] = v.z; kb[3] = v.w; } }
    if (tid < 128) { const float v = bf2f(pr[640 + tid]); p.out[O_SVS + (size_t)b * 16384 + 127 * 128 + tid] = v; kbuf[127 * 129 + tid] = v; }
  }
  __syncthreads();
  { const int h = tid >> 5, d0 = (tid & 31) * 2, kvh = h >> 2;
    float o0 = 0.f, o1 = 0.f;
    for (int kk = 0; kk < 128; ++kk) { float pp = sc[h * 128 + kk]; o0 += pp * kbuf[kk * 129 + kvh * 64 + d0]; o1 += pp * kbuf[kk * 129 + kvh * 64 + d0 + 1]; }
    float z0 = bf2f(pr[768 + h * 64 + d0]), z1 = bf2f(pr[768 + h * 64 + d0 + 1]);
    M[row * 1024 + h * 64 + d0] = f2bf(o0 * siluf_(z0)); M[row * 1024 + h * 64 + d0 + 1] = f2bf(o1 * siluf_(z1)); }
  __syncthreads();
}

DI void dn_sample_item(const Params& p, int item, float* smf) {
  int tid_o = threadIdx.x; asm volatile("" : "+v"(tid_o)); const int tid = tid_o;
  const int b = item >> 2, h = item & 3;
  float* qv = smf; float* kv = smf + 128; float* vv = smf + 256; float* part = smf + 384;
  float* red = part + 1024;
  const bf16_t* P = (const bf16_t*)(p.ws + W_P);
  bf16_t* M = (bf16_t*)(p.ws + W_M);
  const float* sm0 = (const float*)(p.ws + W_SM0);
  const size_t row = (size_t)(NPR + b);
  __syncthreads();
  for (int c = tid; c < 384; c += 256) {
    const int seg = c >> 7, j = c & 127; const int ch = seg * 512 + h * 128 + j;
    const float* cs = p.st_conv + (size_t)b * 3 * 1536 + ch;
    float x0 = cs[0], x1 = cs[1536], x2 = cs[3072], x3 = bf2f(P[row * NA + 1280 + ch]);
    float y = x0 * p.conv_b[ch] + x1 * p.conv_b[1536 + ch] + x2 * p.conv_b[3072 + ch] + x3 * p.conv_b[4608 + ch];
    y = siluf_(y);
    smf[seg * 128 + j] = y;
    float* oc = p.out + O_CVS + (size_t)b * 3 * 1536 + ch; oc[0] = x1; oc[1536] = x2; oc[3072] = x3;
  }
  __syncthreads();
  float ssq = 0.f, ssk = 0.f;
#pragma unroll 4
  for (int i = 0; i < 128; ++i) { float a = qv[i], c = kv[i]; ssq += a * a; ssk += c * c; }
  const float qsc = rsqrtf(ssq + EPS) * 0.08838834764831845f, ksc = rsqrtf(ssk + EPS);
  const float beta = sigmoidf_(sm0[row * 8 + h]);
  const float g = -expf(p.a_log[h]) * softplusf_(sm0[row * 8 + 4 + h] + p.dt_bias[h]);
  const float eg = expf(g);
  const int v4 = (tid & 31) * 4, kg = tid >> 5;
  const float* Sg = p.st_dn + ((size_t)(b * 4 + h) * 128) * 128;
  float4 ps = make_float4(0.f, 0.f, 0.f, 0.f);
  float4 Sv[16];
#pragma unroll
  for (int i = 0; i < 16; ++i) Sv[i] = nt_load4(Sg + (kg + 8 * i) * 128 + v4);
#pragma unroll
  for (int i = 0; i < 16; ++i) { const int k = kg + 8 * i; float kk = kv[k] * ksc; ps.x += kk * Sv[i].x; ps.y += kk * Sv[i].y; ps.z += kk * Sv[i].z; ps.w += kk * Sv[i].w; }
  *(float4*)(part + kg * 128 + v4) = ps;
  __syncthreads();
  if (tid < 128) { float s = 0.f; for (int gI = 0; gI < 8; ++gI) s += part[gI * 128 + tid]; red[tid] = beta * (vv[tid] - eg * s); }
  __syncthreads();
  float4 vn = *(const float4*)(red + v4); float4 po = make_float4(0.f, 0.f, 0.f, 0.f);
  float* So = p.out + O_DNS + ((size_t)(b * 4 + h) * 128) * 128;
#pragma unroll
  for (int i = 0; i < 16; ++i) {
    const int k = kg + 8 * i; const float kk = kv[k] * ksc, qq = qv[k] * qsc;
    float4 s = Sv[i]; s.x = eg * s.x + kk * vn.x; s.y = eg * s.y + kk * vn.y; s.z = eg * s.z + kk * vn.z; s.w = eg * s.w + kk * vn.w;
    nt_store4(So + k * 128 + v4, s);
    po.x += qq * s.x; po.y += qq * s.y; po.z += qq * s.z; po.w += qq * s.w;
  }
  __syncthreads();
  *(float4*)(part + kg * 128 + v4) = po;
  __syncthreads();
  if (tid < 128) { float s = 0.f; for (int gI = 0; gI < 8; ++gI) s += part[gI * 128 + tid]; M[row * 1024 + 512 + h * 128 + tid] = f2bf(s); }
  __syncthreads();
}

DI void gla_sample_item(const Params& p, int item, float* smf) {
  int tid_o = threadIdx.x; asm volatile("" : "+v"(tid_o)); const int tid = tid_o;
  const int vh = item & 1, h = (item >> 1) & 3, b = item >> 3;
  float* qv = smf; float* kv = smf + 128; float* av = smf + 256; float* vv = smf + 384; float* part = smf + 512;
  const bf16_t* P = (const bf16_t*)(p.ws + W_P);
  bf16_t* M = (bf16_t*)(p.ws + W_M);
  const float* sm1 = (const float*)(p.ws + W_SM1);
  const size_t row = (size_t)(NPR + b);
  __syncthreads();
  if (tid < 128) {
    const int k = tid;
    qv[k] = bf2f(P[row * NC + h * 128 + k]) * 0.08838834764831845f;
    kv[k] = bf2f(P[row * NC + 512 + h * 128 + k]);
    float a = p.b_gk[h * 128 + k];
    float g16[16], w16[16];
#pragma unroll
    for (int rr = 0; rr < 16; ++rr) { g16[rr] = sm1[row * 16 + rr]; w16[rr] = p.w_gk_up[rr * 512 + h * 128 + k]; }
#pragma unroll
    for (int rr = 0; rr < 16; ++rr) a += g16[rr] * w16[rr];
    av[k] = expf(logsigmoidf_(a) * (1.f / 16.f));
  } else {
    const int v = tid - 128;
    vv[v] = bf2f(P[row * NC + 1024 + h * 256 + vh * 128 + v]);
  }
  __syncthreads();
  float qk = 0.f;
#pragma unroll 4
  for (int i = 0; i < 128; ++i) qk += qv[i] * kv[i];
  const int v4 = (tid & 31) * 4, kg = tid >> 5;
  const float* Sg = p.st_gla + ((size_t)(b * 4 + h) * 128) * 256 + vh * 128;
  float* So = p.out + O_GLS + ((size_t)(b * 4 + h) * 128) * 256 + vh * 128;
  const float4 v = *(const float4*)(vv + v4);
  float4 po = make_float4(0.f, 0.f, 0.f, 0.f);
  float4 Sv[16];
#pragma unroll
  for (int i = 0; i < 16; ++i) Sv[i] = nt_load4(Sg + (size_t)(kg + 8 * i) * 256 + v4);
#pragma unroll
  for (int i = 0; i < 16; ++i) {
    const int k = kg + 8 * i;
    float4 s = Sv[i];
    const float a = av[k], kk = kv[k], qq = qv[k];
    s.x = a * s.x + kk * v.x; s.y = a * s.y + kk * v.y; s.z = a * s.z + kk * v.z; s.w = a * s.w + kk * v.w;
    nt_store4(So + (size_t)k * 256 + v4, s);
    po.x += qq * s.x; po.y += qq * s.y; po.z += qq * s.z; po.w += qq * s.w;
  }
  (void)qk;
  *(float4*)(part + kg * 128 + v4) = po;
  __syncthreads();
  if (tid < 128) { float s = 0.f; for (int gI = 0; gI < 8; ++gI) s += part[gI * 128 + tid]; M[row * 1024 + h * 256 + vh * 128 + tid] = f2bf(s); }
  __syncthreads();
}

template <int I, int HF>
DI void inv_seg(float (&T)[64], float4 (&an)[8], const float4* Am4, float& a0, float& a1, float& a2, float& a3) {
  constexpr int jlo = HF * 32, jhi = HF == 0 ? (I < 32 ? I : 32) : I;
  constexpr int nq = (jhi - jlo + 3) / 4;
  float4 ac[nq];
#pragma unroll
  for (int q = 0; q < nq; ++q) ac[q] = an[q];
  if (HF == 0 && I > 32) {
    constexpr int n2 = (I - 32 + 3) / 4;
#pragma unroll
    for (int q = 0; q < (n2 > 0 ? n2 : 1); ++q) if (q < n2) an[q] = Am4[I * 16 + 8 + q];
  } else if (I + 1 < 64) {
    constexpr int n2 = ((I + 1 < 32 ? I + 1 : 32) + 3) / 4;
#pragma unroll
    for (int q = 0; q < n2; ++q) an[q] = Am4[(I + 1) * 16 + q];
  }
  __builtin_amdgcn_sched_barrier(0);
#pragma unroll
  for (int j = jlo; j < jhi; ++j) {
    const float4 v4 = ac[(j - jlo) >> 2];
    if ((j & 3) == 0) a0 -= v4.x * T[j]; else if ((j & 3) == 1) a1 -= v4.y * T[j]; else if ((j & 3) == 2) a2 -= v4.z * T[j]; else a3 -= v4.w * T[j];
  }
  __builtin_amdgcn_sched_barrier(0);
}
template <int I>
DI void inv_row(float (&T)[64], float4 (&an)[8], const float4* Am4, int lane) {
  float a0 = (lane == I) ? 1.f : 0.f, a1 = 0.f, a2 = 0.f, a3 = 0.f;
  inv_seg<I, 0>(T, an, Am4, a0, a1, a2, a3);
  if constexpr (I > 32) inv_seg<I, 1>(T, an, Am4, a0, a1, a2, a3);
  T[I] = (a0 + a1) + (a2 + a3);
}
template <int... Is>
DI void inv_all(float (&T)[64], float4 (&an)[8], const float4* Am4, int lane, std::integer_sequence<int, Is...>) { (inv_row<Is + 1>(T, an, Am4, lane), ...); }

DI void dn_prep_item(const Params& p, int ci, unsigned char* smem) {
  int tid_o = threadIdx.x; asm volatile("" : "+v"(tid_o)); const int tid = tid_o, lane = tid & 63, wv = tid >> 6, r = lane & 31, hh = lane >> 5;
  const int n = ci % NCH, bh = ci / NCH, b = bh >> 2, h = bh & 3;
  bf16_t* qs = (bf16_t*)smem;
  bf16_t* ks = qs + 64 * 136;
  bf16_t* kgT = ks + 64 * 136;
  bf16_t* vbT = kgT + 128 * 72;
  float* gcs = (float*)(vbT + 128 * 72);
  float* bts = gcs + 64;
  float* Am = (float*)qs;
  bf16_t* Tb = ks;
  const bf16_t* P = (const bf16_t*)(p.ws + W_P);
  const float* sm0 = (const float*)(p.ws + W_SM0);
  unsigned char* C0 = p.ws + W_C0;
  bf16_t* Cw = (bf16_t*)(C0 + C0_W) + (size_t)ci * 8192;
  bf16_t* CuT = (bf16_t*)(C0 + C0_UT) + (size_t)ci * 8192;
  bf16_t* Cqd = (bf16_t*)(C0 + C0_QD) + (size_t)ci * 8192;
  bf16_t* CkdT = (bf16_t*)(C0 + C0_KDT) + (size_t)ci * 8192;
  bf16_t* Cqk = (bf16_t*)(C0 + C0_QK) + (size_t)ci * 4096;
  float* Cgl = (float*)(p.ws + W_DGL);
  const int t0 = 64 * n - 48;
  __syncthreads();
  if (wv == 0) {
    const int t = t0 + lane; float beta = 0.f, g = 0.f;
    if (t >= 0) { const size_t rr = (size_t)(b * TP + t); beta = sigmoidf_(sm0[rr * 8 + h]); g = -expf(p.a_log[h]) * softplusf_(sm0[rr * 8 + 4 + h] + p.dt_bias[h]); }
    float c = g;
    for (int o = 1; o < 64; o <<= 1) { float u = __shfl_up(c, o); if (lane >= o) c += u; }
    gcs[lane] = c; bts[lane] = beta;
  }
  __syncthreads();
  {
    float cw[3][2][4];
#pragma unroll
    for (int sg = 0; sg < 3; ++sg)
#pragma unroll
      for (int e = 0; e < 2; ++e)
#pragma unroll
        for (int d = 0; d < 4; ++d) cw[sg][e][d] = p.conv_b[d * 1536 + sg * 512 + h * 128 + 2 * lane + e];
#pragma unroll 1
    for (int g4 = 0; g4 < 4; ++g4) {
      const int ib = wv * 16 + g4 * 4;
      unsigned xr[7][3];
#pragma unroll
      for (int rr = 0; rr < 7; ++rr) {
        int t = t0 + ib - 3 + rr; t = t < 0 ? 0 : t;
        const bf16_t* pp = P + (size_t)(b * TP + t) * NA + 1280 + h * 128 + 2 * lane;
#pragma unroll
        for (int sg = 0; sg < 3; ++sg) xr[rr][sg] = *(const unsigned*)(pp + sg * 512);
      }
#pragma unroll
      for (int ii = 0; ii < 4; ++ii) {
        const int i = ib + ii;
        float y[3][2];
#pragma unroll
        for (int sg = 0; sg < 3; ++sg)
#pragma unroll
          for (int e = 0; e < 2; ++e) {
            float a = 0.f;
#pragma unroll
            for (int d = 0; d < 4; ++d) {
              const int tt = t0 + i - 3 + d;
              const unsigned w = xr[ii + d][sg];
              const float xv = __uint_as_float(e == 0 ? (w << 16) : (w & 0xffff0000u));
              a += (tt >= 0 ? xv : 0.f) * cw[sg][e][d];
            }
            y[sg][e] = siluf_(a);
          }
        const float ssq = wsum(y[0][0] * y[0][0] + y[0][1] * y[0][1]);
        const float ssk = wsum(y[1][0] * y[1][0] + y[1][1] * y[1][1]);
        const float qsc = rsqrtf(ssq + EPS) * 0.08838834764831845f, ksc = rsqrtf(ssk + EPS);
        const float gci = gcs[i], bi = bts[i], egi = expf(gci);
        const float q0 = y[0][0] * qsc, q1 = y[0][1] * qsc, k0 = y[1][0] * ksc, k1 = y[1][1] * ksc;
        *(unsigned*)(qs + i * 136 + 2 * lane) = (unsigned)f2bf(q0) | ((unsigned)f2bf(q1) << 16);
        *(unsigned*)(ks + i * 136 + 2 * lane) = (unsigned)f2bf(k0) | ((unsigned)f2bf(k1) << 16);
        kgT[(2 * lane) * 72 + i] = f2bf(k0 * bi * egi); kgT[(2 * lane + 1) * 72 + i] = f2bf(k1 * bi * egi);
        vbT[(2 * lane) * 72 + i] = f2bf(y[2][0] * bi); vbT[(2 * lane + 1) * 72 + i] = f2bf(y[2][1] * bi);
        *(unsigned*)(Cqd + i * 128 + 2 * lane) = (unsigned)f2bf(q0 * egi) | ((unsigned)f2bf(q1 * egi) << 16);
      }
    }
  }
  __syncthreads();
  f32x16 akk = zero16(), aqk = zero16();
  const int mi = wv >> 1, nj = wv & 1;
  {
    const bf16_t* ap = ks + (32 * mi + r) * 136 + 8 * hh;
    const bf16_t* qp = qs + (32 * mi + r) * 136 + 8 * hh;
    const bf16_t* bp = ks + (32 * nj + r) * 136 + 8 * hh;
#pragma unroll
    for (int s = 0; s < 8; ++s) {
      bf16x8 bb = *(const bf16x8*)(bp + 16 * s);
      akk = MFMA32(*(const bf16x8*)(ap + 16 * s), bb, akk);
      aqk = MFMA32(*(const bf16x8*)(qp + 16 * s), bb, aqk);
    }
  }
  __syncthreads();
  {
    const int j = 32 * nj + r; const float gcj = gcs[j];
#pragma unroll
    for (int q = 0; q < 16; ++q) {
      const int i = 32 * mi + crow(q, hh);
      const float dec = i >= j ? expf(gcs[i] - gcj) : 0.f;
      Am[i * 64 + j] = i > j ? bts[i] * akk[q] * dec : 0.f;
      Cqk[i * 64 + j] = f2bf(aqk[q] * dec);
    }
  }
  {
    const float gl = gcs[63];
    for (int e = tid; e < 128 * 16; e += 256) {
      const int k = e >> 4, i4 = (e & 15) * 4;
      float v0 = bf2f(ks[(i4 + 0) * 136 + k]) * expf(gl - gcs[i4 + 0]);
      float v1 = bf2f(ks[(i4 + 1) * 136 + k]) * expf(gl - gcs[i4 + 1]);
      float v2 = bf2f(ks[(i4 + 2) * 136 + k]) * expf(gl - gcs[i4 + 2]);
      float v3 = bf2f(ks[(i4 + 3) * 136 + k]) * expf(gl - gcs[i4 + 3]);
      *(s16x4*)(CkdT + k * 64 + i4) = pack4(v0, v1, v2, v3);
    }
    if (tid == 0) Cgl[ci] = expf(gl);
  }
  __syncthreads();
  if (wv == 0) {
    float T[64];
    const float4* Am4 = (const float4*)Am;
    T[0] = (lane == 0) ? 1.f : 0.f;
    float4 an[8];
    an[0] = Am4[16];
    inv_all(T, an, Am4, lane, std::make_integer_sequence<int, 63>{});
#pragma unroll
    for (int i = 0; i < 64; ++i) Tb[i * 72 + lane] = f2bf(T[i]);
  }
  __syncthreads();
  {
#pragma unroll
    for (int mt = 0; mt < 2; ++mt) {
      f32x16 au = zero16(), aw = zero16();
#pragma unroll
      for (int s = 0; s < 4; ++s) {
        bf16x8 tf = *(const bf16x8*)(Tb + (32 * mt + r) * 72 + 16 * s + 8 * hh);
        bf16x8 vf = *(const bf16x8*)(vbT + (32 * wv + r) * 72 + 16 * s + 8 * hh);
        bf16x8 kf = *(const bf16x8*)(kgT + (32 * wv + r) * 72 + 16 * s + 8 * hh);
        au = MFMA32(tf, vf, au);
        aw = MFMA32(kf, tf, aw);
      }
#pragma unroll
      for (int gq = 0; gq < 4; ++gq) {
        *(s16x4*)(CuT + (32 * wv + r) * 64 + 32 * mt + 8 * gq + 4 * hh) = pack4(au[4 * gq], au[4 * gq + 1], au[4 * gq + 2], au[4 * gq + 3]);
        *(s16x4*)(Cw + (32 * mt + r) * 128 + 32 * wv + 8 * gq + 4 * hh) = pack4(aw[4 * gq], aw[4 * gq + 1], aw[4 * gq + 2], aw[4 * gq + 3]);
      }
    }
  }
  __syncthreads();
}

struct DnRegs { bf16x8 a1[8]; bf16x8 akd[4]; bf16x8 aqk[4]; s16x4 u[4]; float gl; };
DI void dn_load_a(const Params& p, DnRegs& R, int ci, int cb, int wv, int r, int hh) {
  unsigned char* C0 = p.ws + W_C0;
  const bf16_t* A1 = (const bf16_t*)(C0 + (wv < 2 ? C0_W : C0_QD)) + (size_t)ci * 8192 + (32 * (wv & 1) + r) * 128 + 8 * hh;
#pragma unroll
  for (int s = 0; s < 8; ++s) R.a1[s] = *(const bf16x8*)(A1 + 16 * s);
  if (wv < 2) {
    const bf16_t* U = (const bf16_t*)(C0 + C0_UT) + (size_t)ci * 8192 + (cb * 32 + r) * 64 + 32 * (wv & 1) + 4 * hh;
#pragma unroll
    for (int gq = 0; gq < 4; ++gq) R.u[gq] = *(const s16x4*)(U + 8 * gq);
  }
}
DI void dn_load_b(const Params& p, DnRegs& R, int ci, int cb, int wv, int r, int hh) {
  unsigned char* C0 = p.ws + W_C0;
  const bf16_t* Akd = (const bf16_t*)(C0 + C0_KDT) + (size_t)ci * 8192 + (32 * wv + r) * 64 + 8 * hh;
#pragma unroll
  for (int s = 0; s < 4; ++s) R.akd[s] = *(const bf16x8*)(Akd + 16 * s);
  if (wv >= 2) {
    const bf16_t* Aqk = (const bf16_t*)(C0 + C0_QK) + (size_t)ci * 4096 + (32 * (wv & 1) + r) * 64 + 8 * hh;
#pragma unroll
    for (int s = 0; s < 4; ++s) R.aqk[s] = *(const bf16x8*)(Aqk + 16 * s);
  }
  R.gl = ((const float*)(p.ws + W_DGL))[ci];
}
DI void dn_scan_item(const Params& p, int item, unsigned char* smem) {
  int tid_o = threadIdx.x; asm volatile("" : "+v"(tid_o)); const int tid = tid_o, lane = tid & 63, wv = tid >> 6, r = lane & 31, hh = lane >> 5;
  const int bh = item & 7, j_ = item >> 3; const int cb = j_ & 3, g = j_ >> 2, b = bh >> 2, h = bh & 3;
  const int n0 = 3 * g, n1 = n0 + 3;
  bf16_t* SbT = (bf16_t*)smem;
  bf16_t* vnT = SbT + 32 * 136;
  bf16_t* M = (bf16_t*)(p.ws + W_M);
  f32x16 S;
  DnRegs R;
  dn_load_a(p, R, bh * NCH + n0, cb, wv, r, hh);
  dn_load_b(p, R, bh * NCH + n0, cb, wv, r, hh);
  { const float* Sn = p.out + O_GLS + ((size_t)(bh * DN_NG + g) * 128) * 128;
#pragma unroll
    for (int q = 0; q < 16; ++q) S[q] = Sn[(32 * wv + crow(q, hh)) * 128 + cb * 32 + r]; }
  __syncthreads();
  for (int n = n0; n < n1; ++n) {
    const int cin = bh * NCH + (n + 1 < n1 ? n + 1 : n);
#pragma unroll
    for (int gq = 0; gq < 4; ++gq) *(s16x4*)(SbT + r * 136 + 32 * wv + 8 * gq + 4 * hh) = pack4(S[4 * gq], S[4 * gq + 1], S[4 * gq + 2], S[4 * gq + 3]);
    __syncthreads();
    f32x16 acc = zero16();
#pragma unroll
    for (int s = 0; s < 8; ++s) acc = MFMA32(R.a1[s], *(const bf16x8*)(SbT + r * 136 + 16 * s + 8 * hh), acc);
    if (wv < 2) {
#pragma unroll
      for (int gq = 0; gq < 4; ++gq) {
        float v0 = bf2f((bf16_t)R.u[gq][0]) - acc[4 * gq], v1 = bf2f((bf16_t)R.u[gq][1]) - acc[4 * gq + 1];
        float v2 = bf2f((bf16_t)R.u[gq][2]) - acc[4 * gq + 2], v3 = bf2f((bf16_t)R.u[gq][3]) - acc[4 * gq + 3];
        *(s16x4*)(vnT + r * 72 + 32 * (wv & 1) + 8 * gq + 4 * hh) = pack4(v0, v1, v2, v3);
      }
    }
    dn_load_a(p, R, cin, cb, wv, r, hh);
    __syncthreads();
    bf16x8 bv[4];
#pragma unroll
    for (int s = 0; s < 4; ++s) bv[s] = *(const bf16x8*)(vnT + r * 72 + 16 * s + 8 * hh);
#pragma unroll
    for (int q = 0; q < 16; ++q) S[q] *= R.gl;
#pragma unroll
    for (int s = 0; s < 4; ++s) S = MFMA32(R.akd[s], bv[s], S);
    if (wv >= 2) {
#pragma unroll
      for (int s = 0; s < 4; ++s) acc = MFMA32(R.aqk[s], bv[s], acc);
      const int tb = 64 * n - 48 + 32 * (wv & 1);
#pragma unroll
      for (int q = 0; q < 16; ++q) {
        const int t = tb + crow(q, hh);
        if (t >= 0) M[(size_t)(b * TP + t) * 1024 + 512 + h * 128 + cb * 32 + r] = f2bf(acc[q]);
      }
    }
    dn_load_b(p, R, cin, cb, wv, r, hh);
  }
  __syncthreads();
}

struct DnSt { u32x4 w0, w1, w2, w3, k0, k1, k2, k3, u0; float gl; };
DI void dn_l1_load(const Params& p, DnSt& R, int ci, int cb, int tid) {
  unsigned char* C0 = p.ws + W_C0;
  const u32x4* W4 = (const u32x4*)(C0 + C0_W + (size_t)ci * 16384) + tid;
  R.w0 = W4[0]; R.w1 = W4[256]; R.w2 = W4[512]; R.w3 = W4[768];
  const u32x4* K4 = (const u32x4*)(C0 + C0_KDT + (size_t)ci * 16384) + tid;
  R.k0 = K4[0]; R.k1 = K4[256]; R.k2 = K4[512]; R.k3 = K4[768];
  R.u0 = ((const u32x4*)(C0 + C0_UT + (size_t)ci * 16384 + (size_t)cb * 4096))[tid];
  R.gl = ((const float*)(p.ws + W_DGL))[ci];
}
DI void dn_l1_step(const DnSt& R, f32x16& S, unsigned char* smem, int tid, int lane, int wv, int r, int hh) {
  bf16_t* SbT = (bf16_t*)smem;
  bf16_t* vnT = SbT + 32 * 136;
  float4* part = (float4*)(smem + 16384);
  bf16_t* Wl = (bf16_t*)(smem + 24576);
  bf16_t* Kl = (bf16_t*)(smem + 41984);
  bf16_t* Ul = (bf16_t*)(smem + 60416);
  {
    const int i0 = tid, i1 = tid + 256, i2 = tid + 512, i3 = tid + 768;
    *(u32x4*)(Wl + (i0 >> 4) * 136 + (i0 & 15) * 8) = R.w0; *(u32x4*)(Wl + (i1 >> 4) * 136 + (i1 & 15) * 8) = R.w1;
    *(u32x4*)(Wl + (i2 >> 4) * 136 + (i2 & 15) * 8) = R.w2; *(u32x4*)(Wl + (i3 >> 4) * 136 + (i3 & 15) * 8) = R.w3;
    *(u32x4*)(Kl + (i0 >> 3) * 72 + (i0 & 7) * 8) = R.k0; *(u32x4*)(Kl + (i1 >> 3) * 72 + (i1 & 7) * 8) = R.k1;
    *(u32x4*)(Kl + (i2 >> 3) * 72 + (i2 & 7) * 8) = R.k2; *(u32x4*)(Kl + (i3 >> 3) * 72 + (i3 & 7) * 8) = R.k3;
    *(u32x4*)(Ul + (tid >> 3) * 72 + (tid & 7) * 8) = R.u0;
  }
#pragma unroll
  for (int gq = 0; gq < 4; ++gq) *(s16x4*)(SbT + r * 136 + 32 * wv + 8 * gq + 4 * hh) = pack4(S[4 * gq], S[4 * gq + 1], S[4 * gq + 2], S[4 * gq + 3]);
  __syncthreads();
  bf16x8 akd[4];
#pragma unroll
  for (int s = 0; s < 4; ++s) akd[s] = *(const bf16x8*)(Kl + (32 * wv + r) * 72 + 16 * s + 8 * hh);
  s16x4 u[4];
  if (wv < 2) {
#pragma unroll
    for (int gq = 0; gq < 4; ++gq) u[gq] = *(const s16x4*)(Ul + r * 72 + 32 * wv + 8 * gq + 4 * hh);
  }
  f32x16 acc = zero16();
#pragma unroll
  for (int s = 0; s < 4; ++s) acc = MFMA32(*(const bf16x8*)(Wl + (32 * (wv & 1) + r) * 136 + 64 * (wv >> 1) + 16 * s + 8 * hh), *(const bf16x8*)(SbT + r * 136 + 64 * (wv >> 1) + 16 * s + 8 * hh), acc);
  if (wv >= 2) {
#pragma unroll
    for (int gq = 0; gq < 4; ++gq) part[((wv & 1) * 4 + gq) * 64 + lane] = make_float4(acc[4 * gq], acc[4 * gq + 1], acc[4 * gq + 2], acc[4 * gq + 3]);
  }
  __syncthreads();
  if (wv < 2) {
#pragma unroll
    for (int gq = 0; gq < 4; ++gq) {
      const float4 pp = part[(wv * 4 + gq) * 64 + lane];
      float v0 = bf2f((bf16_t)u[gq][0]) - (acc[4 * gq] + pp.x), v1 = bf2f((bf16_t)u[gq][1]) - (acc[4 * gq + 1] + pp.y);
      float v2 = bf2f((bf16_t)u[gq][2]) - (acc[4 * gq + 2] + pp.z), v3 = bf2f((bf16_t)u[gq][3]) - (acc[4 * gq + 3] + pp.w);
      *(s16x4*)(vnT + r * 72 + 32 * wv + 8 * gq + 4 * hh) = pack4(v0, v1, v2, v3);
    }
  }
  __syncthreads();
#pragma unroll
  for (int q = 0; q < 16; ++q) S[q] *= R.gl;
#pragma unroll
  for (int s = 0; s < 4; ++s) S = MFMA32(akd[s], *(const bf16x8*)(vnT + r * 72 + 16 * s + 8 * hh), S);
}
DI void dn_l1_item(const Params& p, int item, unsigned char* smem) {
  int tid_o = threadIdx.x; asm volatile("" : "+v"(tid_o)); const int tid = tid_o, lane = tid & 63, wv = tid >> 6, r = lane & 31, hh = lane >> 5;
  const int bh = item & 7, cb = item >> 3;
  f32x16 S = zero16();
  DnSt R0, R1, R2;
  const int c0 = bh * NCH;
  dn_l1_load(p, R0, c0, cb, tid); dn_l1_load(p, R1, c0 + 1, cb, tid); dn_l1_load(p, R2, c0 + 2, cb, tid);
  __syncthreads();
  for (int it = 0; it < DN_NG; ++it) {
    const int n = 3 * it;
    { float* Sn = p.out + O_GLS + ((size_t)(bh * DN_NG + it) * 128) * 128;
#pragma unroll
      for (int q = 0; q < 16; ++q) Sn[(32 * wv + crow(q, hh)) * 128 + cb * 32 + r] = S[q]; }
    dn_l1_step(R0, S, smem, tid, lane, wv, r, hh); __builtin_amdgcn_sched_barrier(0); dn_l1_load(p, R0, c0 + (n + 3 < NCH ? n + 3 : NCH - 1), cb, tid); __builtin_amdgcn_sched_barrier(0);
    dn_l1_step(R1, S, smem, tid, lane, wv, r, hh); __builtin_amdgcn_sched_barrier(0); dn_l1_load(p, R1, c0 + (n + 4 < NCH ? n + 4 : NCH - 1), cb, tid); __builtin_amdgcn_sched_barrier(0);
    dn_l1_step(R2, S, smem, tid, lane, wv, r, hh); __builtin_amdgcn_sched_barrier(0); dn_l1_load(p, R2, c0 + (n + 5 < NCH ? n + 5 : NCH - 1), cb, tid); __builtin_amdgcn_sched_barrier(0);
  }
  float* So = p.out + O_DNP + (size_t)bh * 128 * 128;
#pragma unroll
  for (int q = 0; q < 16; ++q) So[(32 * wv + crow(q, hh)) * 128 + cb * 32 + r] = S[q];
  __syncthreads();
}

DI void gla_prep_item(const Params& p, int ci, unsigned char* smem) {
  int tid_o = threadIdx.x; asm volatile("" : "+v"(tid_o)); const int tid = tid_o, lane = tid & 63, wv = tid >> 6, r = lane & 31, hh = lane >> 5;
  const int n = ci % NCH, bh = ci / NCH, b = bh >> 2, h = bh & 3;
  float* gks = (float*)smem;
  float* bc = gks + 64 * 16;
  float* tot = bc + 64 * 128;
  bf16_t* qds = (bf16_t*)(tot + 128);
  bf16_t* kis = qds + 64 * 136;
  const bf16_t* P = (const bf16_t*)(p.ws + W_P);
  const float* sm1 = (const float*)(p.ws + W_SM1);
  unsigned char* C1 = p.ws + W_C1;
  bf16_t* Cqd = (bf16_t*)(C1 + C1_QD) + (size_t)ci * 8192;
  bf16_t* CkdT = (bf16_t*)(C1 + C1_KDT) + (size_t)ci * 8192;
  bf16_t* Cqk = (bf16_t*)(C1 + C1_QK) + (size_t)ci * 4096;
  float* Cgl = (float*)(p.ws + W_GGL) + (size_t)ci * 128;
  const int t0 = 64 * n - 48;
  __syncthreads();
  { float gq4[4];
#pragma unroll
    for (int u = 0; u < 4; ++u) { const int i = tid + 256 * u; const int t = t0 + (i >> 4); gq4[u] = sm1[(size_t)(b * TP + (t < 0 ? 0 : t)) * 16 + (i & 15)]; }
#pragma unroll
    for (int u = 0; u < 4; ++u) { const int i = tid + 256 * u; const int t = t0 + (i >> 4); gks[i] = t >= 0 ? gq4[u] : 0.f; } }
  __syncthreads();
  {
    const int k = tid & 127, half = tid >> 7;
    float wu[16];
    for (int rr = 0; rr < 16; ++rr) wu[rr] = p.w_gk_up[rr * 512 + h * 128 + k];
    const float bg = p.b_gk[h * 128 + k];
    float cum = 0.f;
    for (int ii = 0; ii < 32; ++ii) {
      const int i = 32 * half + ii, t = t0 + i;
      float la = 0.f;
      if (t >= 0) { float a = bg; for (int rr = 0; rr < 16; ++rr) a += gks[i * 16 + rr] * wu[rr]; la = logsigmoidf_(a) * (1.f / 16.f); }
      cum += la; bc[i * 128 + k] = cum;
    }
    if (half == 0) tot[k] = cum;
  }
  __syncthreads();
  { const int k = tid & 127, half = tid >> 7;
    if (half == 1) { const float tt = tot[k]; for (int ii = 32; ii < 64; ++ii) bc[ii * 128 + k] += tt; } }
  __syncthreads();
  {
    const int kp = (tid & 63) * 2, isub = tid >> 6;
    unsigned qw[16], kw[16];
#pragma unroll
    for (int m = 0; m < 16; ++m) {
      int t = t0 + isub + 4 * m; t = t < 0 ? 0 : t;
      const bf16_t* pp = P + (size_t)(b * TP + t) * NC + h * 128 + kp;
      qw[m] = *(const unsigned*)pp; kw[m] = *(const unsigned*)(pp + 512);
    }
#pragma unroll
    for (int m = 0; m < 16; ++m) {
      const int i = isub + 4 * m; const bool ok = (t0 + i) >= 0;
      const float2 bcv = *(const float2*)(bc + i * 128 + kp);
      const float q0 = ok ? __uint_as_float(qw[m] << 16) * 0.08838834764831845f : 0.f, q1 = ok ? __uint_as_float(qw[m] & 0xffff0000u) * 0.08838834764831845f : 0.f;
      const float k0 = ok ? __uint_as_float(kw[m] << 16) : 0.f, k1 = ok ? __uint_as_float(kw[m] & 0xffff0000u) : 0.f;
      const unsigned qd = (unsigned)f2bf(q0 * expf(bcv.x)) | ((unsigned)f2bf(q1 * expf(bcv.y)) << 16);
      *(unsigned*)(qds + i * 136 + kp) = qd; *(unsigned*)(Cqd + i * 128 + kp) = qd;
      *(unsigned*)(kis + i * 136 + kp) = (unsigned)f2bf(k0 * expf(-bcv.x)) | ((unsigned)f2bf(k1 * expf(-bcv.y)) << 16);
    }
  }
  __syncthreads();
  for (int e = tid; e < 128 * 16; e += 256) {
    const int k = e >> 4, i4 = (e & 15) * 4; const float eg = expf(bc[63 * 128 + k]);
    *(s16x4*)(CkdT + k * 64 + i4) = pack4(bf2f(kis[(i4 + 0) * 136 + k]) * eg, bf2f(kis[(i4 + 1) * 136 + k]) * eg, bf2f(kis[(i4 + 2) * 136 + k]) * eg, bf2f(kis[(i4 + 3) * 136 + k]) * eg);
  }
  if (tid < 128) Cgl[tid] = expf(bc[63 * 128 + tid]);
  {
    const int mi = wv >> 1, nj = wv & 1;
    f32x16 a = zero16();
#pragma unroll
    for (int s = 0; s < 8; ++s) a = MFMA32(*(const bf16x8*)(qds + (32 * mi + r) * 136 + 16 * s + 8 * hh), *(const bf16x8*)(kis + (32 * nj + r) * 136 + 16 * s + 8 * hh), a);
    const int j = 32 * nj + r;
#pragma unroll
    for (int q = 0; q < 16; ++q) { const int i = 32 * mi + crow(q, hh); Cqk[i * 64 + j] = f2bf(i >= j ? a[q] : 0.f); }
  }
  __syncthreads();
}

struct GlRegs { bf16x8 aq[8]; bf16x8 akd[4]; bf16x8 aqk[4]; bf16x8 bv[4]; float4 gl[4]; };
DI void gl_load_a(const Params& p, GlRegs& R, int bh, int n, int cb, int wv, int r, int hh) {
  const int ci = bh * NCH + n;
  unsigned char* C1 = p.ws + W_C1;
  if (wv < 2) {
    const bf16_t* A1 = (const bf16_t*)(C1 + C1_QD) + (size_t)ci * 8192 + (32 * wv + r) * 128 + 8 * hh;
#pragma unroll
    for (int s = 0; s < 8; ++s) R.aq[s] = *(const bf16x8*)(A1 + 16 * s);
    const bf16_t* Aqk = (const bf16_t*)(C1 + C1_QK) + (size_t)ci * 4096 + (32 * wv + r) * 64 + 8 * hh;
#pragma unroll
    for (int s = 0; s < 4; ++s) R.aqk[s] = *(const bf16x8*)(Aqk + 16 * s);
  }
}
DI void gl_load_b(const Params& p, GlRegs& R, int bh, int n, int cb, int wv, int r, int hh) {
  const int ci = bh * NCH + n; const int b = bh >> 2, h = bh & 3;
  unsigned char* C1 = p.ws + W_C1;
  const bf16_t* Akd = (const bf16_t*)(C1 + C1_KDT) + (size_t)ci * 8192 + (32 * wv + r) * 64 + 8 * hh;
#pragma unroll
  for (int s = 0; s < 4; ++s) R.akd[s] = *(const bf16x8*)(Akd + 16 * s);
  const bf16_t* V = (const bf16_t*)(p.ws + W_PT) + (size_t)(h * 256 + cb * 32 + r) * LDT + 128 + b * TP + 64 * n - 48 + 8 * hh;
#pragma unroll
  for (int s = 0; s < 4; ++s) R.bv[s] = *(const bf16x8*)(V + 16 * s);
  const float* G = (const float*)(p.ws + W_GGL) + (size_t)ci * 128 + 32 * wv + 4 * hh;
#pragma unroll
  for (int gq = 0; gq < 4; ++gq) R.gl[gq] = *(const float4*)(G + 8 * gq);
}
DI void gla_scan_item(const Params& p, int item, unsigned char* smem) {
  int tid_o = threadIdx.x; asm volatile("" : "+v"(tid_o)); const int tid = tid_o, lane = tid & 63, wv = tid >> 6, r = lane & 31, hh = lane >> 5;
  const int bh = item & 7, j_ = item >> 3; const int cb = j_ & 7, g = j_ >> 3, b = bh >> 2, h = bh & 3;
  const int n0 = 6 * g, n1 = (n0 + 6 < NCH) ? n0 + 6 : NCH;
  bf16_t* SbT = (bf16_t*)smem;
  bf16_t* M = (bf16_t*)(p.ws + W_M);
  f32x16 S;
  GlRegs R;
  gl_load_a(p, R, bh, n0, cb, wv, r, hh);
  gl_load_b(p, R, bh, n0, cb, wv, r, hh);
  { const float* Sn = (const float*)(p.ws + W_SNG) + ((size_t)(bh * GLA_NG + g) * 128) * 256;
#pragma unroll
    for (int q = 0; q < 16; ++q) S[q] = Sn[(32 * wv + crow(q, hh)) * 256 + cb * 32 + r]; }
  __syncthreads();
  for (int n = n0; n < n1; ++n) {
    const int nn = n + 1 < n1 ? n + 1 : n;
    bf16_t* Sb = SbT + (n & 1) * 32 * 136;
#pragma unroll
    for (int gq = 0; gq < 4; ++gq) *(s16x4*)(Sb + r * 136 + 32 * wv + 8 * gq + 4 * hh) = pack4(S[4 * gq], S[4 * gq + 1], S[4 * gq + 2], S[4 * gq + 3]);
    __syncthreads();
    if (wv < 2) {
      f32x16 acc = zero16();
#pragma unroll
      for (int s = 0; s < 8; ++s) acc = MFMA32(R.aq[s], *(const bf16x8*)(Sb + r * 136 + 16 * s + 8 * hh), acc);
#pragma unroll
      for (int s = 0; s < 4; ++s) acc = MFMA32(R.aqk[s], R.bv[s], acc);
      gl_load_a(p, R, bh, nn, cb, wv, r, hh);
      const int tb = 64 * n - 48 + 32 * wv;
#pragma unroll
      for (int q = 0; q < 16; ++q) {
        const int t = tb + crow(q, hh);
        if (t >= 0) M[(size_t)(b * TP + t) * 1024 + h * 256 + cb * 32 + r] = f2bf(acc[q]);
      }
    }
#pragma unroll
    for (int gq = 0; gq < 4; ++gq) { S[4 * gq] *= R.gl[gq].x; S[4 * gq + 1] *= R.gl[gq].y; S[4 * gq + 2] *= R.gl[gq].z; S[4 * gq + 3] *= R.gl[gq].w; }
#pragma unroll
    for (int s = 0; s < 4; ++s) S = MFMA32(R.akd[s], R.bv[s], S);
    gl_load_b(p, R, bh, nn, cb, wv, r, hh);
  }
  __syncthreads();
}

struct GlL1 { bf16x8 akd[4]; bf16x8 bv[4]; float4 gl[4]; };
DI void gl_l1_load(const Params& p, GlL1& R, int bh, int n, int cb, int wv, int r, int hh) {
  const int ci = bh * NCH + n; const int b = bh >> 2, h = bh & 3;
  unsigned char* C1 = p.ws + W_C1;
  const bf16_t* Akd = (const bf16_t*)(C1 + C1_KDT) + (size_t)ci * 8192 + (32 * wv + r) * 64 + 8 * hh;
#pragma unroll
  for (int s = 0; s < 4; ++s) R.akd[s] = *(const bf16x8*)(Akd + 16 * s);
  const bf16_t* V = (const bf16_t*)(p.ws + W_PT) + (size_t)(h * 256 + cb * 32 + r) * LDT + 128 + b * TP + 64 * n - 48 + 8 * hh;
#pragma unroll
  for (int s = 0; s < 4; ++s) R.bv[s] = *(const bf16x8*)(V + 16 * s);
  const float* G = (const float*)(p.ws + W_GGL) + (size_t)ci * 128 + 32 * wv + 4 * hh;
#pragma unroll
  for (int gq = 0; gq < 4; ++gq) R.gl[gq] = *(const float4*)(G + 8 * gq);
}
DI void gl_l1_step(const GlL1& R, f32x16& S) {
#pragma unroll
  for (int gq = 0; gq < 4; ++gq) { S[4 * gq] *= R.gl[gq].x; S[4 * gq + 1] *= R.gl[gq].y; S[4 * gq + 2] *= R.gl[gq].z; S[4 * gq + 3] *= R.gl[gq].w; }
#pragma unroll
  for (int s = 0; s < 4; ++s) S = MFMA32(R.akd[s], R.bv[s], S);
}
template <int PROBE>
DI void gla_l1_item(const Params& p, int item) {
  int tid_o = threadIdx.x; asm volatile("" : "+v"(tid_o)); const int tid = tid_o, lane = tid & 63, wv = tid >> 6, r = lane & 31, hh = lane >> 5;
  const int bh = item & 7, cb = item >> 3;
  f32x16 S = zero16();
  GlL1 R0, R1, R2;
  gl_l1_load(p, R0, bh, 0, cb, wv, r, hh); gl_l1_load(p, R1, bh, 1, cb, wv, r, hh); gl_l1_load(p, R2, bh, 2, cb, wv, r, hh);
  for (int it = 0; it < 43; ++it) {
    const int n = 3 * it;
    if (PROBE == 0 && (it & 1) == 0) { float* Sn = (float*)(p.ws + W_SNG) + ((size_t)(bh * GLA_NG + (it >> 1)) * 128) * 256;
#pragma unroll
      for (int q = 0; q < 16; ++q) Sn[(32 * wv + crow(q, hh)) * 256 + cb * 32 + r] = S[q]; }
    gl_l1_step(R0, S); __builtin_amdgcn_sched_barrier(0); if (PROBE != 1) gl_l1_load(p, R0, bh, (n + 3 < NCH ? n + 3 : NCH - 1), cb, wv, r, hh); __builtin_amdgcn_sched_barrier(0);
    gl_l1_step(R1, S); __builtin_amdgcn_sched_barrier(0); if (PROBE != 1) gl_l1_load(p, R1, bh, (n + 4 < NCH ? n + 4 : NCH - 1), cb, wv, r, hh); __builtin_amdgcn_sched_barrier(0);
    gl_l1_step(R2, S); __builtin_amdgcn_sched_barrier(0); if (PROBE != 1) gl_l1_load(p, R2, bh, (n + 5 < NCH ? n + 5 : NCH - 1), cb, wv, r, hh); __builtin_amdgcn_sched_barrier(0);
  }
  float* So = PROBE ? (float*)(p.ws + W_SNG) + (size_t)8 * GLA_NG * 128 * 256 + (size_t)bh * 128 * 256 : p.out + O_GLP + (size_t)bh * 128 * 256;
#pragma unroll
  for (int q = 0; q < 16; ++q) So[(32 * wv + crow(q, hh)) * 256 + cb * 32 + r] = S[q];
}

DI void gla_grp_item(const Params& p, int item) {
  int tid_o = threadIdx.x; asm volatile("" : "+v"(tid_o)); const int tid = tid_o, lane = tid & 63, wv = tid >> 6, r = lane & 31, hh = lane >> 5;
  const int bh = item & 7, j_ = item >> 3; const int cb = j_ & 7, g = j_ >> 3;
  const int n0 = 6 * g, n1 = (n0 + 6 < NCH) ? n0 + 6 : NCH;
  f32x16 S = zero16();
  float4 ap[4];
#pragma unroll
  for (int gq = 0; gq < 4; ++gq) ap[gq] = make_float4(1.f, 1.f, 1.f, 1.f);
  GlL1 R0, R1, R2;
  gl_l1_load(p, R0, bh, n0, cb, wv, r, hh); gl_l1_load(p, R1, bh, n0 + 1, cb, wv, r, hh); gl_l1_load(p, R2, bh, n0 + 2, cb, wv, r, hh);
  for (int n = n0; n < n1; n += 3) {
    const int na = n + 3 < n1 ? n + 3 : n1 - 1, nb = n + 4 < n1 ? n + 4 : n1 - 1, nc = n + 5 < n1 ? n + 5 : n1 - 1;
#pragma unroll
    for (int gq = 0; gq < 4; ++gq) { ap[gq].x *= R0.gl[gq].x; ap[gq].y *= R0.gl[gq].y; ap[gq].z *= R0.gl[gq].z; ap[gq].w *= R0.gl[gq].w; }
    gl_l1_step(R0, S); __builtin_amdgcn_sched_barrier(0); gl_l1_load(p, R0, bh, na, cb, wv, r, hh); __builtin_amdgcn_sched_barrier(0);
#pragma unroll
    for (int gq = 0; gq < 4; ++gq) { ap[gq].x *= R1.gl[gq].x; ap[gq].y *= R1.gl[gq].y; ap[gq].z *= R1.gl[gq].z; ap[gq].w *= R1.gl[gq].w; }
    gl_l1_step(R1, S); __builtin_amdgcn_sched_barrier(0); gl_l1_load(p, R1, bh, nb, cb, wv, r, hh); __builtin_amdgcn_sched_barrier(0);
#pragma unroll
    for (int gq = 0; gq < 4; ++gq) { ap[gq].x *= R2.gl[gq].x; ap[gq].y *= R2.gl[gq].y; ap[gq].z *= R2.gl[gq].z; ap[gq].w *= R2.gl[gq].w; }
    gl_l1_step(R2, S); __builtin_amdgcn_sched_barrier(0); gl_l1_load(p, R2, bh, nc, cb, wv, r, hh); __builtin_amdgcn_sched_barrier(0);
  }
  float* Dg = (float*)(p.ws + W_SNG) + ((size_t)(bh * GLA_NG + g) * 128) * 256;
#pragma unroll
  for (int q = 0; q < 16; ++q) Dg[(32 * wv + crow(q, hh)) * 256 + cb * 32 + r] = S[q];
  if (cb == 0 && r == 0) {
    float* Ag = (float*)(p.ws + W_AG) + (size_t)(bh * GLA_NG + g) * 128 + 32 * wv + 4 * hh;
#pragma unroll
    for (int gq = 0; gq < 4; ++gq) *(float4*)(Ag + 8 * gq) = ap[gq];
  }
}
DI void gla_gscan(const Params& p, int idx) {
  const int bh = idx >> 13, k = (idx >> 6) & 127, v4 = idx & 63;
  float* base = (float*)(p.ws + W_SNG) + ((size_t)(bh * GLA_NG) * 128 + k) * 256 + v4 * 4;
  const float* ab = (const float*)(p.ws + W_AG) + (size_t)(bh * GLA_NG) * 128 + k;
  float4 d[GLA_NG]; float a[GLA_NG];
#pragma unroll
  for (int g = 0; g < GLA_NG; ++g) { d[g] = *(const float4*)(base + (size_t)g * 128 * 256); a[g] = ab[g * 128]; }
  float4 S = make_float4(0.f, 0.f, 0.f, 0.f);
#pragma unroll
  for (int g = 0; g < GLA_NG; ++g) {
    *(float4*)(base + (size_t)g * 128 * 256) = S;
    S.x = a[g] * S.x + d[g].x; S.y = a[g] * S.y + d[g].y; S.z = a[g] * S.z + d[g].z; S.w = a[g] * S.w + d[g].w;
  }
  *(float4*)(p.out + O_GLP + ((size_t)bh * 128 + k) * 256 + v4 * 4) = S;
}

DI void gate0_phase(const Params& p) {
  const int lane = threadIdx.x & 63, wv = threadIdx.x >> 6;
  const bf16_t* P = (const bf16_t*)(p.ws + W_P);
  bf16_t* M = (bf16_t*)(p.ws + W_M);
  float gn[8];
#pragma unroll
  for (int e = 0; e < 8; ++e) gn[e] = p.onorm_b[(lane * 8 + e) & 127];
  const int stride = gridDim.x * 4;
  int r = blockIdx.x * 4 + wv;
  bf16x8 ovn, zvn;
  if (r < NROWS) { ovn = *(const bf16x8*)(M + (size_t)r * 1024 + 512 + lane * 8); zvn = __builtin_nontemporal_load((const bf16x8*)(P + (size_t)r * NA + 2816 + lane * 8)); }
  for (; r < NROWS; r += stride) {
    const bf16x8 ov = ovn, zv = zvn;
    const int rn = r + stride;
    if (rn < NROWS) { ovn = *(const bf16x8*)(M + (size_t)rn * 1024 + 512 + lane * 8); zvn = __builtin_nontemporal_load((const bf16x8*)(P + (size_t)rn * NA + 2816 + lane * 8)); }
    float o[8]; float ss = 0.f;
#pragma unroll
    for (int e = 0; e < 8; ++e) { o[e] = bf2f((bf16_t)ov[e]); ss += o[e] * o[e]; }
    for (int m = 1; m < 16; m <<= 1) ss += __shfl_xor(ss, m);
    const float rs = rsqrtf(ss * (1.f / 128.f) + EPS);
    bf16x8 res;
#pragma unroll
    for (int e = 0; e < 8; ++e) res[e] = (short)f2bf(o[e] * rs * gn[e] * siluf_(bf2f((bf16_t)zv[e])));
    *(bf16x8*)(M + (size_t)r * 1024 + 512 + lane * 8) = res;
  }
}
DI void gate1_phase(const Params& p) {
  const int lane = threadIdx.x & 63, wv = threadIdx.x >> 6;
  const bf16_t* P = (const bf16_t*)(p.ws + W_P);
  bf16_t* M = (bf16_t*)(p.ws + W_M);
  float gn[16];
#pragma unroll
  for (int e = 0; e < 16; ++e) gn[e] = p.onorm_c[(lane * 16 + e) & 255];
  const int stride = gridDim.x * 4;
  int r = blockIdx.x * 4 + wv;
  bf16x8 o0n, o1n, z0n, z1n;
  if (r < NROWS) { o0n = *(const bf16x8*)(M + (size_t)r * 1024 + lane * 16); o1n = *(const bf16x8*)(M + (size_t)r * 1024 + lane * 16 + 8);
                   z0n = __builtin_nontemporal_load((const bf16x8*)(P + (size_t)r * NC + 2048 + lane * 16)); z1n = __builtin_nontemporal_load((const bf16x8*)(P + (size_t)r * NC + 2048 + lane * 16 + 8)); }
  for (; r < NROWS; r += stride) {
    const bf16x8 o0 = o0n, o1 = o1n, z0 = z0n, z1 = z1n;
    const int rn = r + stride;
    if (rn < NROWS) { o0n = *(const bf16x8*)(M + (size_t)rn * 1024 + lane * 16); o1n = *(const bf16x8*)(M + (size_t)rn * 1024 + lane * 16 + 8);
                      z0n = __builtin_nontemporal_load((const bf16x8*)(P + (size_t)rn * NC + 2048 + lane * 16)); z1n = __builtin_nontemporal_load((const bf16x8*)(P + (size_t)rn * NC + 2048 + lane * 16 + 8)); }
    float o[16]; float ss = 0.f;
#pragma unroll
    for (int e = 0; e < 8; ++e) { o[e] = bf2f((bf16_t)o0[e]); o[8 + e] = bf2f((bf16_t)o1[e]); ss += o[e] * o[e] + o[8 + e] * o[8 + e]; }
    for (int m = 1; m < 16; m <<= 1) ss += __shfl_xor(ss, m);
    const float rs = rsqrtf(ss * (1.f / 256.f) + EPS);
    bf16x8 r0, r1;
#pragma unroll
    for (int e = 0; e < 8; ++e) { r0[e] = (short)f2bf(o[e] * rs * gn[e] * siluf_(bf2f((bf16_t)z0[e]))); r1[e] = (short)f2bf(o[8 + e] * rs * gn[8 + e] * siluf_(bf2f((bf16_t)z1[e]))); }
    *(bf16x8*)(M + (size_t)r * 1024 + lane * 16) = r0; *(bf16x8*)(M + (size_t)r * 1024 + lane * 16 + 8) = r1;
  }
}

__global__ void __launch_bounds__(256, 2) fwd_megakernel(Params p) {
  cg::grid_group grid = cg::this_grid();
  __shared__ __attribute__((aligned(16))) unsigned char smem[SMEM_BYTES];
  const int tid = threadIdx.x;
  const int G = gridDim.x, B = blockIdx.x;
  __shared__ uint4 xb_words;
  if (tid == 0) xb_words = make_uint4(0u, 0u, 0u, 0u);
  __syncthreads();
  const XcdBarrier xb = xcd_barrier_post((unsigned*)(p.ws + W_BAR), (volatile LAS unsigned*)&xb_words);
  bf16_t* WtA = (bf16_t*)(p.ws + W_WTA); bf16_t* WoA = (bf16_t*)(p.ws + W_WOA);
  bf16_t* WtC = (bf16_t*)(p.ws + W_WTC); bf16_t* WoC = (bf16_t*)(p.ws + W_WOC);
  bf16_t* P = (bf16_t*)(p.ws + W_P); bf16_t* M = (bf16_t*)(p.ws + W_M); bf16_t* Pt = (bf16_t*)(p.ws + W_PT);
  bf16_t* H0 = (bf16_t*)(p.ws + W_C0); bf16_t* H1 = (bf16_t*)(p.ws + W_C1);

  REP(0) {
  for (int t = B; t < 1088; t += G) {
    if (t < 832) wt_tile(p.w_in_ab, LDA_IN, WtA, t, (float*)smem);
    else wt_tile(p.w_out_ab, 1024, WoA, t - 832, (float*)smem);
  }
  for (int i = B * 256 + tid; i < 128 * 128; i += G * 256) Pt[(size_t)(i >> 7) * LDT + (i & 127)] = 0;
  norm_phase<8, 0>(p, p.norm_ab, p.w_in_ab, LDA_IN, NA, H0, (float*)(p.ws + W_SM0), (float*)smem);
  }
  if (p.coop_flag) grid.sync();
  xcd_barrier(xb);
  REP(1) { gemm_phase<0>(p, H0, WtA, NA / 128, (bf16_t*)smem, B, G);
  xcd_barrier(xb); }
  REP(2) { for (int it = B; it < NCI; it += G) dn_prep_item(p, it, smem); if (DUP == 2) xcd_barrier(xb); }
  for (int i = B * 256 + tid; i < 2 * 128 * 128; i += G * 256) {
    const int b = i >> 14, rr = (i >> 7) & 127, c = i & 127; const size_t row = (size_t)(b * TP + TP - 128 + rr);
    p.out[O_SKP + i] = bf2f(P[row * NA + 512 + c]); p.out[O_SVP + i] = bf2f(P[row * NA + 640 + c]);
  }
  for (int i = B * 256 + tid; i < 2 * 3 * 1536; i += G * 256) {
    const int b = i / 4608, rr = (i / 1536) % 3, c = i % 1536;
    p.out[O_CVP + i] = bf2f(P[(size_t)(b * TP + TP - 3 + rr) * NA + 1280 + c]);
  }
  xcd_barrier(xb);
  if (DUP == 13) { if (B < 32) dn_l1_item(p, B, smem); xcd_barrier(xb); }
  if (DUP == 14) { if (B >= 32) for (int it = B - 32; it < 2 * 65 * 8; it += G - 32) swa_prompt_item(p, it); xcd_barrier(xb); }
  REP(15) {
  if (B < 32) dn_l1_item(p, B, smem);
  else {
    const int W = G - 32, wb = B - 32;
    for (int it = wb; it < 2 * 65 * 8; it += W) swa_prompt_item(p, it);
    for (int it = W - 1 - wb; it < 128; it += W) swa_sample_item(p, it, (float*)smem);
    for (int it = (wb + 200) % W; it < 512; it += W) dn_sample_item(p, it, (float*)smem);
    for (int t = wb; t < 1024; t += W) {
      if (t < 768) wt_tile(p.w_in_c, LDC_IN, WtC, t, (float*)smem);
      else wt_tile(p.w_out_c, 1024, WoC, t - 768, (float*)smem);
    }
  }
  xcd_barrier(xb);
  }
  REP(3) { for (int it = B; it < 32 * DN_NG; it += G) dn_scan_item(p, it, smem);
  xcd_barrier(xb); }
  gate0_phase(p);
  xcd_barrier(xb);
  REP(5) { gemm_phase<1>(p, M, WoA, 8, (bf16_t*)smem, B, G);
  xcd_barrier(xb); }
  for (int i = B * 256 + tid; i < 1024 * 128; i += G * 256) Pt[(size_t)(i >> 7) * LDT + (i & 127)] = 0;
  REP(6) {
  norm_phase<16, 1>(p, p.norm_c, p.w_in_c, LDC_IN, NC, H1, (float*)(p.ws + W_SM1), (float*)smem);
  }
  xcd_barrier(xb);
  gemm_phase<2>(p, H1, WtC, NC / 128, (bf16_t*)smem, B, G);
  xcd_barrier(xb);
  REP(8) { for (int it = B; it < NCI; it += G) gla_prep_item(p, it, smem); if (DUP == 8) xcd_barrier(xb); }
  xcd_barrier(xb);
  for (int it = B; it < 64 * GLA_NG; it += G) gla_grp_item(p, it);
  for (int it = G - 1 - B; it < 1024; it += G) gla_sample_item(p, it, (float*)smem);
  xcd_barrier(xb);
  for (int idx = B * 256 + tid; idx < 8 * 128 * 64; idx += G * 256) gla_gscan(p, idx);
  xcd_barrier(xb);
  REP(9) { for (int it = B; it < 64 * GLA_NG; it += G) gla_scan_item(p, it, smem);
  xcd_barrier(xb); }
  gate1_phase(p);
  xcd_barrier(xb);
  gemm_phase<3>(p, M, WoC, 8, (bf16_t*)smem, B, G);
  xcd_barrier(xb);
  {
    const int lane = tid & 63, wv = tid >> 6;
    float4 gv[4];
#pragma unroll
    for (int i = 0; i < 4; ++i) gv[i] = *(const float4*)(p.final_norm + 4 * lane + 256 * i);
    const int stride = G * 4;
    int r = B * 4 + wv;
    float4 xn[4];
    if (r < NROWS) { const float* yr = yrow(p, r);
#pragma unroll
      for (int i = 0; i < 4; ++i) xn[i] = nt_load4(yr + 4 * lane + 256 * i); }
    for (; r < NROWS; r += stride) {
      float4 xc[4];
#pragma unroll
      for (int i = 0; i < 4; ++i) xc[i] = xn[i];
      const int rn = r + stride;
      if (rn < NROWS) { const float* yn = yrow(p, rn);
#pragma unroll
        for (int i = 0; i < 4; ++i) xn[i] = nt_load4(yn + 4 * lane + 256 * i); }
      if (r < NPR) { const int t = r >= TP ? r - TP : r; if (t < 16) continue; }
      float* yr = yrow(p, r);
      float ss = 0.f;
#pragma unroll
      for (int i = 0; i < 4; ++i) ss += xc[i].x * xc[i].x + xc[i].y * xc[i].y + xc[i].z * xc[i].z + xc[i].w * xc[i].w;
      ss = wsum(ss);
      const float rstd = rsqrtf(ss * (1.f / 1024.f) + EPS);
#pragma unroll
      for (int i = 0; i < 4; ++i) nt_store4(yr + 4 * lane + 256 * i, make_float4(xc[i].x * rstd * gv[i].x, xc[i].y * rstd * gv[i].y, xc[i].z * rstd * gv[i].z, xc[i].w * rstd * gv[i].w));
    }
  }
}

extern "C" void kernel_launch(void* const* d_in, const int* in_sizes, int n_in, void* d_out,
                              int out_size, void* d_ws, size_t ws_size, hipStream_t stream) {
  static int grid_blocks = 0;
  if (!grid_blocks) {
    int dev = 0, cus = 0, per_cu = 0;
    (void)hipGetDevice(&dev);
    (void)hipDeviceGetAttribute(&cus, hipDeviceAttributeMultiprocessorCount, dev);
    (void)hipOccupancyMaxActiveBlocksPerMultiprocessor(&per_cu, fwd_megakernel, 256, 0);
    if (per_cu > 2) per_cu = 2;
    if (per_cu < 1) per_cu = 1;
    grid_blocks = cus * per_cu;
  }
  Params p{};
  const float* const* in = (const float* const*)d_in;
  p.x_prompt = in[0]; p.x_sample = in[1]; p.cache_k = in[2]; p.cache_v = in[3];
  p.st_conv = in[4]; p.st_dn = in[5]; p.st_gla = in[6]; p.meta = in[7];
  p.norm_ab = in[8]; p.w_in_ab = in[9]; p.sink = in[10]; p.conv_b = in[11];
  p.a_log = in[12]; p.dt_bias = in[13]; p.onorm_b = in[14]; p.w_out_ab = in[15];
  p.norm_c = in[16]; p.w_in_c = in[17]; p.w_gk_up = in[18]; p.b_gk = in[19];
  p.onorm_c = in[20]; p.w_out_c = in[21]; p.final_norm = in[22];
  p.out = (float*)d_out; p.ws = (unsigned char*)d_ws;
  (void)hipMemsetAsync((unsigned char*)d_ws + W_BAR, 0, XCD_BAR_WORDS * 4, stream);
  void* args[] = {&p};
  hipError_t e = hipLaunchCooperativeKernel((void*)fwd_megakernel, dim3(grid_blocks), dim3(256), args, 0, stream);
  if (e != hipSuccess) fprintf(stderr, "cooperative launch failed: %s (grid %d)\n", hipGetErrorString(e), grid_blocks);
}
```

```cpp
#include <hip/hip_runtime.h>
#include <hip/hip_cooperative_groups.h>
#include <cstdio>
#include <utility>
namespace cg = cooperative_groups;

typedef unsigned short bf16_t;
typedef __attribute__((ext_vector_type(8))) short bf16x8;
typedef __attribute__((ext_vector_type(4))) short s16x4;
typedef __attribute__((ext_vector_type(16))) float f32x16;
typedef __attribute__((ext_vector_type(4))) unsigned u32x4;
typedef __attribute__((ext_vector_type(4))) float f32x4;
__device__ __forceinline__ float4 nt_load4(const float* p) { const f32x4 v = __builtin_nontemporal_load((const f32x4*)p); return make_float4(v[0], v[1], v[2], v[3]); }
__device__ __forceinline__ void nt_store4(float* p, const float4& a) { f32x4 v; v[0] = a.x; v[1] = a.y; v[2] = a.z; v[3] = a.w; __builtin_nontemporal_store(v, (f32x4*)p); }

#define DI __device__ __forceinline__
#define MFMA32(a, b, c) __builtin_amdgcn_mfma_f32_32x32x16_bf16((a), (b), (c), 0, 0, 0)

constexpr int D = 1024;
constexpr int TP = 8208;
constexpr int NPR = 2 * TP;
constexpr int NROWS = NPR + 128;
constexpr int MP = 16640;
constexpr int NA = 3328;
constexpr int NC = 3072;
constexpr int LDA_IN = 3336;
constexpr int LDC_IN = 3088;
constexpr int LDT = MP + 128;
constexpr int NCH = 129;
constexpr int NCI = 8 * NCH;
constexpr float EPS = 1e-6f;

constexpr size_t O_YP = 0;
constexpr size_t O_YS = O_YP + (size_t)2 * 8192 * 1024;
constexpr size_t O_SKP = O_YS + 128 * 1024;
constexpr size_t O_SVP = O_SKP + 2 * 128 * 128;
constexpr size_t O_CVP = O_SVP + 2 * 128 * 128;
constexpr size_t O_DNP = O_CVP + 2 * 3 * 1536;
constexpr size_t O_GLP = O_DNP + 2 * 4 * 128 * 128;
constexpr size_t O_SKS = O_GLP + 2 * 4 * 128 * 256;
constexpr size_t O_SVS = O_SKS + (size_t)128 * 128 * 128;
constexpr size_t O_CVS = O_SVS + (size_t)128 * 128 * 128;
constexpr size_t O_DNS = O_CVS + (size_t)128 * 3 * 1536;
constexpr size_t O_GLS = O_DNS + (size_t)128 * 4 * 128 * 128;

constexpr size_t al256(size_t x) { return (x + 255) & ~(size_t)255; }
constexpr size_t W_WTA = 0;
constexpr size_t W_WOA = W_WTA + (size_t)NA * 1024 * 2;
constexpr size_t W_WTC = W_WOA + (size_t)1024 * 1024 * 2;
constexpr size_t W_WOC = W_WTC + (size_t)NC * 1024 * 2;
constexpr size_t W_SM0 = W_WOC + (size_t)1024 * 1024 * 2;
constexpr size_t W_SM1 = W_SM0 + (size_t)MP * 8 * 4;
constexpr size_t W_YME = W_SM1 + (size_t)MP * 16 * 4;
constexpr size_t W_DGL = W_YME + (size_t)32 * 1024 * 4;
constexpr size_t W_GGL = al256(W_DGL + (size_t)NCI * 4);
constexpr size_t W_BAR = al256(W_GGL + (size_t)NCI * 128 * 4);
constexpr size_t W_P = al256(W_BAR + 3456 * 4);
constexpr size_t W_M = W_P + (size_t)MP * NA * 2;
constexpr size_t W_X = W_M + (size_t)MP * 1024 * 2;
constexpr size_t W_PT = W_X;
constexpr size_t W_C0 = W_X + (size_t)128 * LDT * 2;
constexpr size_t W_C1 = W_X + (size_t)1024 * LDT * 2;
constexpr size_t C0_W = 0;
constexpr size_t C0_UT = C0_W + (size_t)NCI * 8192 * 2;
constexpr size_t C0_QD = C0_UT + (size_t)NCI * 8192 * 2;
constexpr size_t C0_KDT = C0_QD + (size_t)NCI * 8192 * 2;
constexpr size_t C0_QK = C0_KDT + (size_t)NCI * 8192 * 2;
constexpr size_t W_SNG = al256(W_C1 + (size_t)NCI * 40960);
constexpr size_t W_AG = W_SNG + (size_t)8 * 22 * 128 * 256 * 4;
constexpr int DN_NG = 43, GLA_NG = 22;
constexpr size_t C1_QD = 0;
constexpr size_t C1_KDT = C1_QD + (size_t)NCI * 8192 * 2;
constexpr size_t C1_QK = C1_KDT + (size_t)NCI * 8192 * 2;

constexpr int SMEM_BYTES = 74752;
#ifndef DUP
#define DUP -1
#endif
#define REP(k) for (int rep_ = 0; rep_ < (DUP == (k) ? 2 : 1); ++rep_)

struct Params {
  const float* x_prompt; const float* x_sample; const float* cache_k; const float* cache_v;
  const float* st_conv; const float* st_dn; const float* st_gla; const float* meta;
  const float* norm_ab; const float* w_in_ab; const float* sink; const float* conv_b;
  const float* a_log; const float* dt_bias; const float* onorm_b; const float* w_out_ab;
  const float* norm_c; const float* w_in_c; const float* w_gk_up; const float* b_gk;
  const float* onorm_c; const float* w_out_c; const float* final_norm;
  float* out; unsigned char* ws;
  int coop_flag; int pad_;
};

DI bf16_t f2bf(float x) { unsigned u = __float_as_uint(x); u += 0x7fffu + ((u >> 16) & 1u); return (bf16_t)(u >> 16); }
DI float bf2f(bf16_t s) { return __uint_as_float(((unsigned)s) << 16); }
DI s16x4 pack4(float a, float b, float c, float d) { s16x4 v; v[0] = (short)f2bf(a); v[1] = (short)f2bf(b); v[2] = (short)f2bf(c); v[3] = (short)f2bf(d); return v; }
DI int crow(int reg, int h) { return (reg & 3) + 8 * (reg >> 2) + 4 * h; }
DI float wsum(float v) { for (int o = 32; o > 0; o >>= 1) v += __shfl_xor(v, o); return v; }
DI float sigmoidf_(float x) { return 1.f / (1.f + __expf(-x)); }
DI float siluf_(float x) { return x / (1.f + __expf(-x)); }
DI float softplusf_(float x) { return x > 20.f ? x : log1pf(expf(x)); }
DI float logsigmoidf_(float x) { return fminf(x, 0.f) - log1pf(expf(-fabsf(x))); }
DI f32x16 zero16() { f32x16 z; for (int i = 0; i < 16; ++i) z[i] = 0.f; return z; }

DI const float* xrow_v(const float* xs, const float* xm, const float* xp, int r) {
  const bool smp = r >= NPR;
  const int b = (!smp && r >= TP) ? 1 : 0;
  const int t = r - b * TP;
  const bool met = !smp && t < 16;
  const float* base = smp ? xs : (met ? xm : xp);
  const int off = smp ? (r - NPR) : (met ? t : (b * 8192 + t - 16));
  return base + (size_t)off * D;
}
DI float* yrow_v(float* ys, float* ym, float* yp, int r) {
  const bool smp = r >= NPR;
  const int b = (!smp && r >= TP) ? 1 : 0;
  const int t = r - b * TP;
  const bool met = !smp && t < 16;
  float* base = smp ? ys : (met ? ym : yp);
  const int off = smp ? (r - NPR) : (met ? (b * 16 + t) : (b * 8192 + t - 16));
  return base + (size_t)off * D;
}
DI const float* xrow(const Params& p, int r) { const float* xs = p.x_sample; const float* xm = p.meta; const float* xp = p.x_prompt; return xrow_v(xs, xm, xp, r); }
DI float* yrow(const Params& p, int r) { float* o = p.out; unsigned char* w = p.ws; return yrow_v(o + O_YS, (float*)(w + W_YME), o + O_YP, r); }

#define XB_TMO      128
#define XB_XCNT(j)  (256  + 64 * (j))
#define XB_XSUB(j)  (1280 + 64 * (j))
#define XB_XGEN(j)  (2304 + 64 * (j))
#define XB_TOP      3328
#define XB_TOPGEN   3392
#define XCD_BAR_WORDS 3456
#define XB_SPIN_CAP (1u << 20)
#define LAS __attribute__((address_space(3)))
DI unsigned xb_ld(unsigned* p)              { return __hip_atomic_load(p, __ATOMIC_RELAXED, __HIP_MEMORY_SCOPE_AGENT); }
DI unsigned xb_add(unsigned* p, unsigned v) { return __hip_atomic_fetch_add(p, v, __ATOMIC_RELAXED, __HIP_MEMORY_SCOPE_AGENT); }
DI unsigned xb_xcc_id() { return (unsigned)__builtin_amdgcn_s_getreg((3 << 11) | 20) & 0xFu; }
#define XB_SPIN(cond, bar) do { unsigned _sp = 0; while (cond) { __builtin_amdgcn_s_sleep(3); \
    if ((++_sp & 255u) == 0u) { if (xb_ld(&(bar)[XB_TMO])) break; if (_sp > XB_SPIN_CAP) { atomicAdd(&(bar)[XB_TMO], 1u); break; } } } } while (0)
struct XcdBarrier { unsigned* bar; unsigned x; volatile LAS unsigned* st; };
DI XcdBarrier xcd_barrier_post(unsigned* bar, volatile LAS unsigned* st) {
  XcdBarrier b; b.bar = bar; b.x = xb_xcc_id(); b.st = st;
  if (threadIdx.x == 0) (void)xb_add(&bar[XB_XCNT(b.x)], 1u);
  return b;
}
DI void xcd_barrier_complete(unsigned* bar, unsigned x, unsigned& nloc, unsigned& nx) {
  const unsigned G = gridDim.x * gridDim.y * gridDim.z;
  unsigned sum, cnt, mine, sp = 0u;
  for (;;) {
    sum = 0u; cnt = 0u; mine = 0u;
#pragma unroll
    for (unsigned j = 0; j < 16; ++j) { const unsigned c = xb_ld(&bar[XB_XCNT(j)]); sum += c; cnt += (c > 0u) ? 1u : 0u; mine = (j == x) ? c : mine; }
    if (sum == G) break;
    __builtin_amdgcn_s_sleep(1);
    if ((++sp & 255u) == 0u) { if (xb_ld(&bar[XB_TMO])) break; if (sp > XB_SPIN_CAP) { atomicAdd(&bar[XB_TMO], 1u); break; } }
  }
  nloc = mine > 0u ? mine : 1u; nx = cnt > 0u ? cnt : 1u;
}
DI void xcd_barrier(const XcdBarrier& b) {
  asm volatile("s_waitcnt vmcnt(0)" ::: "memory");
  __syncthreads();
  if (threadIdx.x < 64 && b.st[0] == 0u) {
    const unsigned ln = threadIdx.x;
    const unsigned Gt = gridDim.x * gridDim.y * gridDim.z;
    unsigned c = 0u, sum = 0u, cnt = 0u, mine = 0u, sp = 0u;
    for (;;) {
      c = ln < 16u ? xb_ld(&b.bar[XB_XCNT(ln)]) : 0u;
      sum = c; cnt = c > 0u ? 1u : 0u; mine = (ln == b.x) ? c : 0u;
      for (int o = 32; o > 0; o >>= 1) { sum += __shfl_xor(sum, o); cnt += __shfl_xor(cnt, o); mine += __shfl_xor(mine, o); }
      if (sum == Gt || ++sp > XB_SPIN_CAP) break;
      __builtin_amdgcn_s_sleep(1);
    }
    if (ln == 0u) { b.st[1] = cnt > 0u ? cnt : 1u; b.st[0] = mine > 0u ? mine : 1u; }
  }
  if (threadIdx.x == 0) {
    unsigned* bar = b.bar;
    __builtin_amdgcn_s_waitcnt(0);
    unsigned nloc = b.st[0], nx = b.st[1];
    if (nloc == 0u) { xcd_barrier_complete(bar, b.x, nloc, nx); b.st[0] = nloc; b.st[1] = nx; }
    const unsigned old = xb_add(&bar[XB_XSUB(b.x)], 1u);
    const unsigned gen = old / nloc;
    if (old + 1u == (gen + 1u) * nloc) {
      __builtin_amdgcn_fence(__ATOMIC_RELEASE, "agent");
      asm volatile("s_waitcnt vmcnt(0)" ::: "memory");
      const unsigned og = xb_add(&bar[XB_TOP], 1u);
      const unsigned tg = og / nx;
      if (og + 1u == (tg + 1u) * nx) xb_add(&bar[XB_TOPGEN], 1u);
      else XB_SPIN(xb_ld(&bar[XB_TOPGEN]) == tg, bar);
      __builtin_amdgcn_fence(__ATOMIC_ACQUIRE, "agent");
      xb_add(&bar[XB_XGEN(b.x)], 1u);
      asm volatile("s_waitcnt vmcnt(0)" ::: "memory");
    } else {
      XB_SPIN(xb_ld(&bar[XB_XGEN(b.x)]) == gen, bar);
      __builtin_amdgcn_fence(__ATOMIC_ACQUIRE, "agent");
      asm volatile("s_waitcnt vmcnt(0)" ::: "memory");
    }
  }
  __syncthreads();
}

DI void wt_tile(const float* src, int ld, bf16_t* dst, int tile, float* tl) {
  int tid_o = threadIdx.x; asm volatile("" : "+v"(tid_o)); const int tid = tid_o;
  const int k0 = (tile & 15) * 64, n0 = (tile >> 4) * 64;
  float tv[16];
#pragma unroll
  for (int i = 0; i < 16; ++i) { const int idx = tid + 256 * i; const int kk = idx >> 6, nn = idx & 63; tv[i] = __builtin_nontemporal_load(src + (size_t)(k0 + kk) * ld + n0 + nn); }
#pragma unroll
  for (int i = 0; i < 16; ++i) { const int idx = tid + 256 * i; const int kk = idx >> 6, nn = idx & 63; tl[kk * 65 + nn] = tv[i]; }
  __syncthreads();
#pragma unroll
  for (int i = 0; i < 16; ++i) { const int idx = tid + 256 * i; const int nn = idx >> 6, kk = idx & 63; dst[(size_t)(n0 + nn) * 1024 + k0 + kk] = f2bf(tl[kk * 65 + nn]); }
  __syncthreads();
}

template <int NS, int LAYER>
DI void norm_phase(const Params& p, const float* g, const float* wsm, int ldw, int ncol0, bf16_t* hb, float* small, float* Ws) {
  int tid_o = threadIdx.x; asm volatile("" : "+v"(tid_o)); const int tid = tid_o, lane = tid & 63, wv = tid >> 6;
  __syncthreads();
  for (int i0 = tid; i0 < 1024 * NS; i0 += 256 * 8) {
    float wv8[8];
#pragma unroll
    for (int u = 0; u < 8; ++u) { const int i = i0 + 256 * u; wv8[u] = wsm[(size_t)(i / NS) * ldw + ncol0 + (i % NS)]; }
#pragma unroll
    for (int u = 0; u < 8; ++u) { const int i = i0 + 256 * u; Ws[(i % NS) * 1024 + (i / NS)] = wv8[u]; }
  }
  __syncthreads();
  float4 gv[4];
#pragma unroll
  for (int i = 0; i < 4; ++i) gv[i] = *(const float4*)(g + 4 * lane + 256 * i);
  const int stride = gridDim.x * 4;
  int r = blockIdx.x * 4 + wv;
  float4 xn[4];
  if (r < NROWS) { const float* xr = LAYER == 0 ? xrow(p, r) : (const float*)yrow(p, r);
#pragma unroll
    for (int i = 0; i < 4; ++i) xn[i] = nt_load4(xr + 4 * lane + 256 * i); }
  for (; r < MP; r += stride) {
    float4 xc[4];
#pragma unroll
    for (int i = 0; i < 4; ++i) xc[i] = xn[i];
    const int rn = r + stride;
    if (rn < NROWS) { const float* xr = LAYER == 0 ? xrow(p, rn) : (const float*)yrow(p, rn);
#pragma unroll
      for (int i = 0; i < 4; ++i) xn[i] = nt_load4(xr + 4 * lane + 256 * i); }
    if (r >= NROWS) {
#pragma unroll
      for (int i = 0; i < 4; ++i) *(s16x4*)(hb + (size_t)r * D + 4 * lane + 256 * i) = pack4(0.f, 0.f, 0.f, 0.f);
      if (lane < NS) small[(size_t)r * NS + lane] = 0.f;
      continue;
    }
    float ss = 0.f;
#pragma unroll
    for (int i = 0; i < 4; ++i) ss += xc[i].x * xc[i].x + xc[i].y * xc[i].y + xc[i].z * xc[i].z + xc[i].w * xc[i].w;
    ss = wsum(ss);
    const float rstd = rsqrtf(ss * (1.f / 1024.f) + EPS);
    float acc[NS];
#pragma unroll
    for (int c = 0; c < NS; ++c) acc[c] = 0.f;
#pragma unroll
    for (int i = 0; i < 4; ++i) {
      const float h0 = xc[i].x * rstd * gv[i].x, h1 = xc[i].y * rstd * gv[i].y, h2 = xc[i].z * rstd * gv[i].z, h3 = xc[i].w * rstd * gv[i].w;
      *(s16x4*)(hb + (size_t)r * D + 4 * lane + 256 * i) = pack4(h0, h1, h2, h3);
#pragma unroll
      for (int c = 0; c < NS; ++c) { const float4 w4 = *(const float4*)(Ws + c * 1024 + 4 * lane + 256 * i); acc[c] += h0 * w4.x + h1 * w4.y + h2 * w4.z + h3 * w4.w; }
    }
#pragma unroll
    for (int c = 0; c < NS; ++c) acc[c] = wsum(acc[c]);
    if (lane == 0) { float4* so = (float4*)(small + (size_t)r * NS);
#pragma unroll
      for (int c4 = 0; c4 < NS / 4; ++c4) so[c4] = make_float4(acc[c4 * 4], acc[c4 * 4 + 1], acc[c4 * 4 + 2], acc[c4 * 4 + 3]); }
  }
  __syncthreads();
}

struct G8 { uint4 a0, a1, a2, a3, b0, b1, b2, b3; };
DI void gemm_gload(G8& g, const bf16_t* Ag, const bf16_t* Bg, int kt) {
  g.a0 = *(const uint4*)(Ag + kt * 64); g.a1 = *(const uint4*)(Ag + (size_t)32 * 1024 + kt * 64); g.a2 = *(const uint4*)(Ag + (size_t)64 * 1024 + kt * 64); g.a3 = *(const uint4*)(Ag + (size_t)96 * 1024 + kt * 64);
  g.b0 = *(const uint4*)(Bg + kt * 64); g.b1 = *(const uint4*)(Bg + (size_t)32 * 1024 + kt * 64); g.b2 = *(const uint4*)(Bg + (size_t)64 * 1024 + kt * 64); g.b3 = *(const uint4*)(Bg + (size_t)96 * 1024 + kt * 64);
}
DI void gemm_swrite(const G8& g, bf16_t* Asw, bf16_t* Bsw, int buf) {
  bf16_t* a = Asw + buf * 128 * 72; bf16_t* b = Bsw + buf * 128 * 72;
  *(uint4*)(a) = g.a0; *(uint4*)(a + 32 * 72) = g.a1; *(uint4*)(a + 64 * 72) = g.a2; *(uint4*)(a + 96 * 72) = g.a3;
  *(uint4*)(b) = g.b0; *(uint4*)(b + 32 * 72) = g.b1; *(uint4*)(b + 64 * 72) = g.b2; *(uint4*)(b + 96 * 72) = g.b3;
}
DI void gemm_comp(f32x16& c00, f32x16& c01, f32x16& c10, f32x16& c11, const bf16_t* Ab, const bf16_t* Bb, int co0, int co1, int co2, int co3) {
#define GK(CO) { bf16x8 a0 = *(const bf16x8*)(Ab + (CO)), a1 = *(const bf16x8*)(Ab + 32 * 64 + (CO)); bf16x8 b0 = *(const bf16x8*)(Bb + (CO)), b1 = *(const bf16x8*)(Bb + 32 * 64 + (CO)); \
    c00 = MFMA32(a0, b0, c00); c01 = MFMA32(a0, b1, c01); c10 = MFMA32(a1, b0, c10); c11 = MFMA32(a1, b1, c11); }
  GK(co0) GK(co1) GK(co2) GK(co3)
#undef GK
}
template <int EPI>
DI void gemm_tile(const Params& p, const bf16_t* __restrict__ A, const bf16_t* __restrict__ Bt, int m0, int n0, bf16_t* sm) {
  int tid_o = threadIdx.x; asm volatile("" : "+v"(tid_o)); const int tid = tid_o, lane = tid & 63, wv = tid >> 6, r = lane & 31, hh = lane >> 5;
  const int wm = wv >> 1, wn = wv & 1;
  bf16_t* As = sm;
  bf16_t* Bs = sm + 2 * 128 * 64;
  f32x16 c00 = zero16(), c01 = zero16(), c10 = zero16(), c11 = zero16();
  const int lrow = tid >> 3, lkc = (tid & 7) * 8;
  const bf16_t* Ag = A + (size_t)(m0 + lrow) * 1024 + lkc;
  const bf16_t* Bg = Bt + (size_t)(n0 + lrow) * 1024 + lkc;
  const int ch = tid & 7, swz = (lrow >> 1) & 7;
  bf16_t* Asw = As + lrow * 64 + ((ch ^ swz) << 3); bf16_t* Bsw = Bs + lrow * 64 + ((ch ^ swz) << 3);
  const int rk = (r >> 1) & 7;
  const bf16_t* Abase = As + (wm * 64 + r) * 64; const bf16_t* Bbase = Bs + (wn * 64 + r) * 64;
  const int co0 = ((0 + hh) ^ rk) << 3, co1 = ((2 + hh) ^ rk) << 3, co2 = ((4 + hh) ^ rk) << 3, co3 = ((6 + hh) ^ rk) << 3;
  uint4 pa0, pa1, pa2, pa3, pb0, pb1, pb2, pb3, qa0, qa1, qa2, qa3, qb0, qb1, qb2, qb3;
#define GLD(X, KT) X##a0 = *(const uint4*)(Ag + (KT) * 64); X##a1 = *(const uint4*)(Ag + 32 * 1024 + (KT) * 64); X##a2 = *(const uint4*)(Ag + 64 * 1024 + (KT) * 64); X##a3 = *(const uint4*)(Ag + 96 * 1024 + (KT) * 64); \
                   X##b0 = *(const uint4*)(Bg + (KT) * 64); X##b1 = *(const uint4*)(Bg + 32 * 1024 + (KT) * 64); X##b2 = *(const uint4*)(Bg + 64 * 1024 + (KT) * 64); X##b3 = *(const uint4*)(Bg + 96 * 1024 + (KT) * 64);
#define SWR(X, BUF) *(uint4*)(Asw + (BUF) * 8192) = X##a0; *(uint4*)(Asw + (BUF) * 8192 + 32 * 64) = X##a1; *(uint4*)(Asw + (BUF) * 8192 + 64 * 64) = X##a2; *(uint4*)(Asw + (BUF) * 8192 + 96 * 64) = X##a3; \
                    *(uint4*)(Bsw + (BUF) * 8192) = X##b0; *(uint4*)(Bsw + (BUF) * 8192 + 32 * 64) = X##b1; *(uint4*)(Bsw + (BUF) * 8192 + 64 * 64) = X##b2; *(uint4*)(Bsw + (BUF) * 8192 + 96 * 64) = X##b3;
  GLD(p, 0) GLD(q, 1)
  SWR(p, 0) __syncthreads();
  for (int kt = 0; kt < 16; kt += 2) {
    if (kt + 2 < 16) { GLD(p, kt + 2) }
    __builtin_amdgcn_sched_barrier(0);
    gemm_comp(c00, c01, c10, c11, Abase, Bbase, co0, co1, co2, co3);
    SWR(q, 1)
    __syncthreads();
    if (kt + 3 < 16) { GLD(q, kt + 3) }
    __builtin_amdgcn_sched_barrier(0);
    gemm_comp(c00, c01, c10, c11, Abase + 8192, Bbase + 8192, co0, co1, co2, co3);
    if (kt + 2 < 16) { SWR(p, 0) }
    __syncthreads();
  }
#undef GLD
#undef SWR
  f32x16 acc[2][2]; acc[0][0] = c00; acc[0][1] = c01; acc[1][0] = c10; acc[1][1] = c11;
  const float* xbs = p.x_sample; const float* xbm = p.meta; const float* xbp = p.x_prompt;
  float* ybs = p.out + O_YS; float* ybm = (float*)(p.ws + W_YME); float* ybp = p.out + O_YP;
  bf16_t* P = (bf16_t*)(p.ws + W_P);
  bf16_t* Pt = (bf16_t*)(p.ws + W_PT);
#pragma unroll
  for (int i = 0; i < 2; ++i)
#pragma unroll
    for (int j = 0; j < 2; ++j) {
      const int n = n0 + wn * 64 + 32 * j + r;
      const int mb = m0 + wm * 64 + 32 * i;
      if (EPI == 0 || EPI == 2) {
        const int ldp = EPI == 0 ? NA : NC;
#pragma unroll
        for (int q = 0; q < 16; ++q) P[(size_t)(mb + crow(q, hh)) * ldp + n] = f2bf(acc[i][j][q]);
        const int tlo = EPI == 0 ? 640 : 1024, thi = EPI == 0 ? 768 : 2048;
        if (n >= tlo && n < thi) {
#pragma unroll
          for (int gq = 0; gq < 4; ++gq)
            *(s16x4*)(Pt + (size_t)(n - tlo) * LDT + 128 + mb + 8 * gq + 4 * hh) = pack4(acc[i][j][4 * gq], acc[i][j][4 * gq + 1], acc[i][j][4 * gq + 2], acc[i][j][4 * gq + 3]);
        }
      } else {
        float* yp[16]; float rv[16];
#pragma unroll
        for (int q = 0; q < 16; ++q) {
          const int m = mb + crow(q, hh);
          const int mc = m < NROWS ? m : NROWS - 1;
          yp[q] = yrow_v(ybs, ybm, ybp, mc) + n;
          rv[q] = EPI == 1 ? __builtin_nontemporal_load(xrow_v(xbs, xbm, xbp, mc) + n) : __builtin_nontemporal_load(yp[q]);
        }
#pragma unroll
        for (int q = 0; q < 16; ++q) {
          const int m = mb + crow(q, hh);
          if (m < NROWS) *yp[q] = rv[q] + acc[i][j][q];
        }
      }
    }
}

template <int EPI>
DI void gemm_phase(const Params& p, const bf16_t* A, const bf16_t* Bt, int NT, bf16_t* sm, int wg0, int nwg) {
  constexpr int MT = MP / 128;
  const int x = wg0 & 7, w = wg0 >> 3, nw = nwg >> 3;
  const int mlo = (x * MT) >> 3, mhi = ((x + 1) * MT) >> 3, Mx = mhi - mlo;
  const int full = NT >> 3, rem = NT & 7, Tx = Mx * NT, fullT = full * 8 * Mx;
  for (int j = w; j < Tx; j += nw) {
    int mi, nt;
    if (j < fullT) { const int ng = j / (8 * Mx), jj = j - ng * 8 * Mx; mi = jj >> 3; nt = ng * 8 + (jj & 7); }
    else { const int jj = j - fullT; mi = jj / rem; nt = full * 8 + (jj - mi * rem); }
    gemm_tile<EPI>(p, A, Bt, (mlo + mi) * 128, nt * 128, sm);
  }
}

DI void swa_prompt_item(const Params& p, int item) {
  int tid_o = threadIdx.x; asm volatile("" : "+v"(tid_o)); const int tid = tid_o, lane = tid & 63, wv = tid >> 6, r = lane & 31, hh = lane >> 5;
  const int hd = item & 7; const int qb = (item >> 3) % 65; const int b = item / (8 * 65);
  const int kvh = hd >> 2;
  const bf16_t* P = (const bf16_t*)(p.ws + W_P);
  const bf16_t* Pt = (const bf16_t*)(p.ws + W_PT);
  bf16_t* M = (bf16_t*)(p.ws + W_M);
  const int tq = qb * 128 + wv * 32 + r;
  const int tqc = tq < TP ? tq : TP - 1;
  const int kb0 = qb * 128 - 128 + 32 * wv;
  bf16x8 qf[4];
  { const bf16_t* qp = P + (size_t)(b * TP + tqc) * NA + hd * 64 + 8 * hh;
    for (int ks = 0; ks < 4; ++ks) qf[ks] = __builtin_nontemporal_load((const bf16x8*)(qp + 16 * ks)); }
  f32x16 st[5];
#pragma unroll
  for (int j = 0; j < 5; ++j) {
    int kp = kb0 + 32 * j + r; kp = kp < 0 ? 0 : (kp > TP - 1 ? TP - 1 : kp);
    const bf16_t* kptr = P + (size_t)(b * TP + kp) * NA + 512 + kvh * 64 + 8 * hh;
    f32x16 a = zero16();
#pragma unroll
    for (int ks = 0; ks < 4; ++ks) { bf16x8 kf = *(const bf16x8*)(kptr + 16 * ks); a = MFMA32(kf, qf[ks], a); }
    st[j] = a;
  }
  const float sk = p.sink[hd];
  float mx = -1e30f;
#pragma unroll
  for (int j = 0; j < 5; ++j)
#pragma unroll
    for (int q = 0; q < 16; ++q) {
      int kp = kb0 + 32 * j + crow(q, hh); int df = tq - kp;
      bool ok = (kp >= 0) && (df >= 0) && (df < 128);
      float s = ok ? st[j][q] * 0.125f : -1e30f;
      st[j][q] = s; mx = fmaxf(mx, s);
    }
  mx = fmaxf(mx, __shfl_xor(mx, 32));
  mx = fmaxf(mx, sk);
  float sum = 0.f;
#pragma unroll
  for (int j = 0; j < 5; ++j)
#pragma unroll
    for (int q = 0; q < 16; ++q) { float s = st[j][q]; float e = s > -1e29f ? __expf(s - mx) : 0.f; st[j][q] = e; sum += e; }
  sum += __shfl_xor(sum, 32);
  const float inv = 1.f / (sum + __expf(sk - mx));
  f32x16 ot[2]; ot[0] = zero16(); ot[1] = zero16();
#pragma unroll
  for (int j = 0; j < 5; ++j)
#pragma unroll
    for (int s = 0; s < 2; ++s) {
      bf16x8 pf;
#pragma unroll
      for (int e = 0; e < 8; ++e) pf[e] = (short)f2bf(st[j][8 * s + e]);
      const int kidx = 128 + b * TP + kb0 + 32 * j + 16 * s + 4 * hh;
#pragma unroll
      for (int dt = 0; dt < 2; ++dt) {
        const bf16_t* vp = Pt + (size_t)(kvh * 64 + dt * 32 + r) * LDT + kidx;
        s16x4 lo = *(const s16x4*)(vp), hi = *(const s16x4*)(vp + 8);
        bf16x8 vf = __builtin_shufflevector(lo, hi, 0, 1, 2, 3, 4, 5, 6, 7);
        ot[dt] = MFMA32(vf, pf, ot[dt]);
      }
    }
  if (tq < TP) {
    const size_t row = (size_t)(b * TP + tq);
#pragma unroll
    for (int dt = 0; dt < 2; ++dt)
#pragma unroll
      for (int gq = 0; gq < 4; ++gq) {
        const int d = dt * 32 + 8 * gq + 4 * hh;
        s16x4 z4 = __builtin_nontemporal_load((const s16x4*)(P + row * NA + 768 + hd * 64 + d));
        float o0 = ot[dt][4 * gq] * inv * siluf_(bf2f((bf16_t)z4[0]));
        float o1 = ot[dt][4 * gq + 1] * inv * siluf_(bf2f((bf16_t)z4[1]));
        float o2 = ot[dt][4 * gq + 2] * inv * siluf_(bf2f((bf16_t)z4[2]));
        float o3 = ot[dt][4 * gq + 3] * inv * siluf_(bf2f((bf16_t)z4[3]));
        *(s16x4*)(M + row * 1024 + hd * 64 + d) = pack4(o0, o1, o2, o3);
      }
  }
}

DI void swa_sample_item(const Params& p, int b, float* smf) {
  int tid_o = threadIdx.x; asm volatile("" : "+v"(tid_o)); const int tid = tid_o, lane = tid & 63, wv = tid >> 6;
  float* kbuf = smf;
  float* sc = smf + 128 * 129;
  float* qsh = sc + 8 * 128;
  const bf16_t* P = (const bf16_t*)(p.ws + W_P);
  bf16_t* M = (bf16_t*)(p.ws + W_M);
  const size_t row = (size_t)(NPR + b);
  const bf16_t* pr = P + row * NA;
  __syncthreads();
  for (int i = tid; i < 512; i += 256) qsh[i] = bf2f(pr[i]);
  {
    const float4* src = (const float4*)(p.cache_k + (size_t)b * 16384 + 128);
    float4* dst = (float4*)(p.out + O_SKS + (size_t)b * 16384);
    float4 cv[16];
#pragma unroll
    for (int j = 0; j < 16; ++j) { const int i4 = tid + 256 * j; cv[j] = nt_load4((const float*)(src + (i4 < 127 * 32 ? i4 : 0))); }
#pragma unroll
    for (int j = 0; j < 16; ++j) { const int i4 = tid + 256 * j; if (i4 < 127 * 32) { const float4 v = cv[j]; nt_store4((float*)(dst + i4), v); float* kb = kbuf + (i4 >> 5) * 129 + (i4 & 31) * 4; kb[0] = v.x; kb[1] = v.y; kb[2] = v.z; kb[3] = v.w; } }
    if (tid < 128) { const float v = bf2f(pr[512 + tid]); p.out[O_SKS + (size_t)b * 16384 + 127 * 128 + tid] = v; kbuf[127 * 129 + tid] = v; }
  }
  __syncthreads();
  { const int kk = tid & 127, kvh = tid >> 7;
    float d0 = 0.f, d1 = 0.f, d2 = 0.f, d3 = 0.f;
    for (int d = 0; d < 64; ++d) { float kv = kbuf[kk * 129 + kvh * 64 + d]; const float* qq = qsh + kvh * 256 + d; d0 += qq[0] * kv; d1 += qq[64] * kv; d2 += qq[128] * kv; d3 += qq[192] * kv; }
    sc[(kvh * 4 + 0) * 128 + kk] = d0 * 0.125f; sc[(kvh * 4 + 1) * 128 + kk] = d1 * 0.125f; sc[(kvh * 4 + 2) * 128 + kk] = d2 * 0.125f; sc[(kvh * 4 + 3) * 128 + kk] = d3 * 0.125f; }
  __syncthreads();
  for (int hq = 0; hq < 2; ++hq) {
    const int h = wv * 2 + hq; const float sk = p.sink[h];
    float s0 = sc[h * 128 + lane], s1 = sc[h * 128 + lane + 64];
    float m = fmaxf(s0, s1); for (int o = 32; o > 0; o >>= 1) m = fmaxf(m, __shfl_xor(m, o)); m = fmaxf(m, sk);
    float e0 = __expf(s0 - m), e1 = __expf(s1 - m); float sum = wsum(e0 + e1);
    float inv = 1.f / (sum + __expf(sk - m));
    sc[h * 128 + lane] = e0 * inv; sc[h * 128 + lane + 64] = e1 * inv;
  }
  __syncthreads();
  {
    const float4* src = (const float4*)(p.cache_v + (size_t)b * 16384 + 128);
    float4* dst = (float4*)(p.out + O_SVS + (size_t)b * 16384);
    float4 cv[16];
#pragma unroll
    for (int j = 0; j < 16; ++j) { const int i4 = tid + 256 * j; cv[j] = nt_load4((const float*)(src + (i4 < 127 * 32 ? i4 : 0))); }
#pragma unroll
    for (int j = 0; j < 16; ++j) { const int i4 = tid + 256 * j; if (i4 < 127 * 32) { const float4 v = cv[j]; nt_store4((float*)(dst + i4), v); float* kb = kbuf + (i4 >> 5) * 129 + (i4 & 31) * 4; kb[0] = v.x; kb[1] = v.y; kb[2] = v.z; kb[3] = v.w; } }
    if (tid < 128) { const float v = bf2f(pr[640 + tid]); p.out[O_SVS + (size_t)b * 16384 + 127 * 128 + tid] = v; kbuf[127 * 129 + tid] = v; }
  }
  __syncthreads();
  { const int h = tid >> 5, d0 = (tid & 31) * 2, kvh = h >> 2;
    float o0 = 0.f, o1 = 0.f;
    for (int kk = 0; kk < 128; ++kk) { float pp = sc[h * 128 + kk]; o0 += pp * kbuf[kk * 129 + kvh * 64 + d0]; o1 += pp * kbuf[kk * 129 + kvh * 64 + d0 + 1]; }
    float z0 = bf2f(pr[768 + h * 64 + d0]), z1 = bf2f(pr[768 + h * 64 + d0 + 1]);
    M[row * 1024 + h * 64 + d0] = f2bf(o0 * siluf_(z0)); M[row * 1024 + h * 64 + d0 + 1] = f2bf(o1 * siluf_(z1)); }
  __syncthreads();
}

DI void dn_sample_item(const Params& p, int item, float* smf) {
  int tid_o = threadIdx.x; asm volatile("" : "+v"(tid_o)); const int tid = tid_o;
  const int b = item >> 2, h = item & 3;
  float* qv = smf; float* kv = smf + 128; float* vv = smf + 256; float* part = smf + 384;
  float* red = part + 1024;
  const bf16_t* P = (const bf16_t*)(p.ws + W_P);
  bf16_t* M = (bf16_t*)(p.ws + W_M);
  const float* sm0 = (const float*)(p.ws + W_SM0);
  const size_t row = (size_t)(NPR + b);
  __syncthreads();
  for (int c = tid; c < 384; c += 256) {
    const int seg = c >> 7, j = c & 127; const int ch = seg * 512 + h * 128 + j;
    const float* cs = p.st_conv + (size_t)b * 3 * 1536 + ch;
    float x0 = cs[0], x1 = cs[1536], x2 = cs[3072], x3 = bf2f(P[row * NA + 1280 + ch]);
    float y = x0 * p.conv_b[ch] + x1 * p.conv_b[1536 + ch] + x2 * p.conv_b[3072 + ch] + x3 * p.conv_b[4608 + ch];
    y = siluf_(y);
    smf[seg * 128 + j] = y;
    float* oc = p.out + O_CVS + (size_t)b * 3 * 1536 + ch; oc[0] = x1; oc[1536] = x2; oc[3072] = x3;
  }
  __syncthreads();
  float ssq = 0.f, ssk = 0.f;
#pragma unroll 4
  for (int i = 0; i < 128; ++i) { float a = qv[i], c = kv[i]; ssq += a * a; ssk += c * c; }
  const float qsc = rsqrtf(ssq + EPS) * 0.08838834764831845f, ksc = rsqrtf(ssk + EPS);
  const float beta = sigmoidf_(sm0[row * 8 + h]);
  const float g = -expf(p.a_log[h]) * softplusf_(sm0[row * 8 + 4 + h] + p.dt_bias[h]);
  const float eg = expf(g);
  const int v4 = (tid & 31) * 4, kg = tid >> 5;
  const float* Sg = p.st_dn + ((size_t)(b * 4 + h) * 128) * 128;
  float4 ps = make_float4(0.f, 0.f, 0.f, 0.f);
  float4 Sv[16];
#pragma unroll
  for (int i = 0; i < 16; ++i) Sv[i] = nt_load4(Sg + (kg + 8 * i) * 128 + v4);
#pragma unroll
  for (int i = 0; i < 16; ++i) { const int k = kg + 8 * i; float kk = kv[k] * ksc; ps.x += kk * Sv[i].x; ps.y += kk * Sv[i].y; ps.z += kk * Sv[i].z; ps.w += kk * Sv[i].w; }
  *(float4*)(part + kg * 128 + v4) = ps;
  __syncthreads();
  if (tid < 128) { float s = 0.f; for (int gI = 0; gI < 8; ++gI) s += part[gI * 128 + tid]; red[tid] = beta * (vv[tid] - eg * s); }
  __syncthreads();
  float4 vn = *(const float4*)(red + v4); float4 po = make_float4(0.f, 0.f, 0.f, 0.f);
  float* So = p.out + O_DNS + ((size_t)(b * 4 + h) * 128) * 128;
#pragma unroll
  for (int i = 0; i < 16; ++i) {
    const int k = kg + 8 * i; const float kk = kv[k] * ksc, qq = qv[k] * qsc;
    float4 s = Sv[i]; s.x = eg * s.x + kk * vn.x; s.y = eg * s.y + kk * vn.y; s.z = eg * s.z + kk * vn.z; s.w = eg * s.w + kk * vn.w;
    nt_store4(So + k * 128 + v4, s);
    po.x += qq * s.x; po.y += qq * s.y; po.z += qq * s.z; po.w += qq * s.w;
  }
  __syncthreads();
  *(float4*)(part + kg * 128 + v4) = po;
  __syncthreads();
  if (tid < 128) { float s = 0.f; for (int gI = 0; gI < 8; ++gI) s += part[gI * 128 + tid]; M[row * 1024 + 512 + h * 128 + tid] = f2bf(s); }
  __syncthreads();
}

DI void gla_sample_item(const Params& p, int item, float* smf) {
  int tid_o = threadIdx.x; asm volatile("" : "+v"(tid_o)); const int tid = tid_o;
  const int vh = item & 1, h = (item >> 1) & 3, b = item >> 3;
  float* qv = smf; float* kv = smf + 128; float* av = smf + 256; float* vv = smf + 384; float* part = smf + 512;
  const bf16_t* P = (const bf16_t*)(p.ws + W_P);
  bf16_t* M = (bf16_t*)(p.ws + W_M);
  const float* sm1 = (const float*)(p.ws + W_SM1);
  const size_t row = (size_t)(NPR + b);
  __syncthreads();
  if (tid < 128) {
    const int k = tid;
    qv[k] = bf2f(P[row * NC + h * 128 + k]) * 0.08838834764831845f;
    kv[k] = bf2f(P[row * NC + 512 + h * 128 + k]);
    float a = p.b_gk[h * 128 + k];
    float g16[16], w16[16];
#pragma unroll
    for (int rr = 0; rr < 16; ++rr) { g16[rr] = sm1[row * 16 + rr]; w16[rr] = p.w_gk_up[rr * 512 + h * 128 + k]; }
#pragma unroll
    for (int rr = 0; rr < 16; ++rr) a += g16[rr] * w16[rr];
    av[k] = expf(logsigmoidf_(a) * (1.f / 16.f));
  } else {
    const int v = tid - 128;
    vv[v] = bf2f(P[row * NC + 1024 + h * 256 + vh * 128 + v]);
  }
  __syncthreads();
  float qk = 0.f;
#pragma unroll 4
  for (int i = 0; i < 128; ++i) qk += qv[i] * kv[i];
  const int v4 = (tid & 31) * 4, kg = tid >> 5;
  const float* Sg = p.st_gla + ((size_t)(b * 4 + h) * 128) * 256 + vh * 128;
  float* So = p.out + O_GLS + ((size_t)(b * 4 + h) * 128) * 256 + vh * 128;
  const float4 v = *(const float4*)(vv + v4);
  float4 po = make_float4(0.f, 0.f, 0.f, 0.f);
  float4 Sv[16];
#pragma unroll
  for (int i = 0; i < 16; ++i) Sv[i] = nt_load4(Sg + (size_t)(kg + 8 * i) * 256 + v4);
#pragma unroll
  for (int i = 0; i < 16; ++i) {
    const int k = kg + 8 * i;
    float4 s = Sv[i];
    const float a = av[k], kk = kv[k], qq = qv[k];
    s.x = a * s.x + kk * v.x; s.y = a * s.y + kk * v.y; s.z = a * s.z + kk * v.z; s.w = a * s.w + kk * v.w;
    nt_store4(So + (size_t)k * 256 + v4, s);
    po.x += qq * s.x; po.y += qq * s.y; po.z += qq * s.z; po.w += qq * s.w;
  }
  (void)qk;
  *(float4*)(part + kg * 128 + v4) = po;
  __syncthreads();
  if (tid < 128) { float s = 0.f; for (int gI = 0; gI < 8; ++gI) s += part[gI * 128 + tid]; M[row * 1024 + h * 256 + vh * 128 + tid] = f2bf(s); }
  __syncthreads();
}

template <int I, int HF>
DI void inv_seg(float (&T)[64], float4 (&an)[8], const float4* Am4, float& a0, float& a1, float& a2, float& a3) {
  constexpr int jlo = HF * 32, jhi = HF == 0 ? (I < 32 ? I : 32) : I;
  constexpr int nq = (jhi - jlo + 3) / 4;
  float4 ac[nq];
#pragma unroll
  for (int q = 0; q < nq; ++q) ac[q] = an[q];
  if (HF == 0 && I > 32) {
    constexpr int n2 = (I - 32 + 3) / 4;
#pragma unroll
    for (int q = 0; q < (n2 > 0 ? n2 : 1); ++q) if (q < n2) an[q] = Am4[I * 16 + 8 + q];
  } else if (I + 1 < 64) {
    constexpr int n2 = ((I + 1 < 32 ? I + 1 : 32) + 3) / 4;
#pragma unroll
    for (int q = 0; q < n2; ++q) an[q] = Am4[(I + 1) * 16 + q];
  }
  __builtin_amdgcn_sched_barrier(0);
#pragma unroll
  for (int j = jlo; j < jhi; ++j) {
    const float4 v4 = ac[(j - jlo) >> 2];
    if ((j & 3) == 0) a0 -= v4.x * T[j]; else if ((j & 3) == 1) a1 -= v4.y * T[j]; else if ((j & 3) == 2) a2 -= v4.z * T[j]; else a3 -= v4.w * T[j];
  }
  __builtin_amdgcn_sched_barrier(0);
}
template <int I>
DI void inv_row(float (&T)[64], float4 (&an)[8], const float4* Am4, int lane) {
  float a0 = (lane == I) ? 1.f : 0.f, a1 = 0.f, a2 = 0.f, a3 = 0.f;
  inv_seg<I, 0>(T, an, Am4, a0, a1, a2, a3);
  if constexpr (I > 32) inv_seg<I, 1>(T, an, Am4, a0, a1, a2, a3);
  T[I] = (a0 + a1) + (a2 + a3);
}
template <int... Is>
DI void inv_all(float (&T)[64], float4 (&an)[8], const float4* Am4, int lane, std::integer_sequence<int, Is...>) { (inv_row<Is + 1>(T, an, Am4, lane), ...); }

DI void dn_prep_item(const Params& p, int ci, unsigned char* smem) {
  int tid_o = threadIdx.x; asm volatile("" : "+v"(tid_o)); const int tid = tid_o, lane = tid & 63, wv = tid >> 6, r = lane & 31, hh = lane >> 5;
  const int n = ci % NCH, bh = ci / NCH, b = bh >> 2, h = bh & 3;
  bf16_t* qs = (bf16_t*)smem;
  bf16_t* ks = qs + 64 * 136;
  bf16_t* kgT = ks + 64 * 136;
  bf16_t* vbT = kgT + 128 * 72;
  float* gcs = (float*)(vbT + 128 * 72);
  float* bts = gcs + 64;
  float* Am = (float*)qs;
  bf16_t* Tb = ks;
  const bf16_t* P = (const bf16_t*)(p.ws + W_P);
  const float* sm0 = (const float*)(p.ws + W_SM0);
  unsigned char* C0 = p.ws + W_C0;
  bf16_t* Cw = (bf16_t*)(C0 + C0_W) + (size_t)ci * 8192;
  bf16_t* CuT = (bf16_t*)(C0 + C0_UT) + (size_t)ci * 8192;
  bf16_t* Cqd = (bf16_t*)(C0 + C0_QD) + (size_t)ci * 8192;
  bf16_t* CkdT = (bf16_t*)(C0 + C0_KDT) + (size_t)ci * 8192;
  bf16_t* Cqk = (bf16_t*)(C0 + C0_QK) + (size_t)ci * 4096;
  float* Cgl = (float*)(p.ws + W_DGL);
  const int t0 = 64 * n - 48;
  __syncthreads();
  if (wv == 0) {
    const int t = t0 + lane; float beta = 0.f, g = 0.f;
    if (t >= 0) { const size_t rr = (size_t)(b * TP + t); beta = sigmoidf_(sm0[rr * 8 + h]); g = -expf(p.a_log[h]) * softplusf_(sm0[rr * 8 + 4 + h] + p.dt_bias[h]); }
    float c = g;
    for (int o = 1; o < 64; o <<= 1) { float u = __shfl_up(c, o); if (lane >= o) c += u; }
    gcs[lane] = c; bts[lane] = beta;
  }
  __syncthreads();
  {
    float cw[3][2][4];
#pragma unroll
    for (int sg = 0; sg < 3; ++sg)
#pragma unroll
      for (int e = 0; e < 2; ++e)
#pragma unroll
        for (int d = 0; d < 4; ++d) cw[sg][e][d] = p.conv_b[d * 1536 + sg * 512 + h * 128 + 2 * lane + e];
#pragma unroll 1
    for (int g4 = 0; g4 < 4; ++g4) {
      const int ib = wv * 16 + g4 * 4;
      unsigned xr[7][3];
#pragma unroll
      for (int rr = 0; rr < 7; ++rr) {
        int t = t0 + ib - 3 + rr; t = t < 0 ? 0 : t;
        const bf16_t* pp = P + (size_t)(b * TP + t) * NA + 1280 + h * 128 + 2 * lane;
#pragma unroll
        for (int sg = 0; sg < 3; ++sg) xr[rr][sg] = *(const unsigned*)(pp + sg * 512);
      }
#pragma unroll
      for (int ii = 0; ii < 4; ++ii) {
        const int i = ib + ii;
        float y[3][2];
#pragma unroll
        for (int sg = 0; sg < 3; ++sg)
#pragma unroll
          for (int e = 0; e < 2; ++e) {
            float a = 0.f;
#pragma unroll
            for (int d = 0; d < 4; ++d) {
              const int tt = t0 + i - 3 + d;
              const unsigned w = xr[ii + d][sg];
              const float xv = __uint_as_float(e == 0 ? (w << 16) : (w & 0xffff0000u));
              a += (tt >= 0 ? xv : 0.f) * cw[sg][e][d];
            }
            y[sg][e] = siluf_(a);
          }
        const float ssq = wsum(y[0][0] * y[0][0] + y[0][1] * y[0][1]);
        const float ssk = wsum(y[1][0] * y[1][0] + y[1][1] * y[1][1]);
        const float qsc = rsqrtf(ssq + EPS) * 0.08838834764831845f, ksc = rsqrtf(ssk + EPS);
        const float gci = gcs[i], bi = bts[i], egi = expf(gci);
        const float q0 = y[0][0] * qsc, q1 = y[0][1] * qsc, k0 = y[1][0] * ksc, k1 = y[1][1] * ksc;
        *(unsigned*)(qs + i * 136 + 2 * lane) = (unsigned)f2bf(q0) | ((unsigned)f2bf(q1) << 16);
        *(unsigned*)(ks + i * 136 + 2 * lane) = (unsigned)f2bf(k0) | ((unsigned)f2bf(k1) << 16);
        kgT[(2 * lane) * 72 + i] = f2bf(k0 * bi * egi); kgT[(2 * lane + 1) * 72 + i] = f2bf(k1 * bi * egi);
        vbT[(2 * lane) * 72 + i] = f2bf(y[2][0] * bi); vbT[(2 * lane + 1) * 72 + i] = f2bf(y[2][1] * bi);
        *(unsigned*)(Cqd + i * 128 + 2 * lane) = (unsigned)f2bf(q0 * egi) | ((unsigned)f2bf(q1 * egi) << 16);
      }
    }
  }
  __syncthreads();
  f32x16 akk = zero16(), aqk = zero16();
  const int mi = wv >> 1, nj = wv & 1;
  {
    const bf16_t* ap = ks + (32 * mi + r) * 136 + 8 * hh;
    const bf16_t* qp = qs + (32 * mi + r) * 136 + 8 * hh;
    const bf16_t* bp = ks + (32 * nj + r) * 136 + 8 * hh;
#pragma unroll
    for (int s = 0; s < 8; ++s) {
      bf16x8 bb = *(const bf16x8*)(bp + 16 * s);
      akk = MFMA32(*(const bf16x8*)(ap + 16 * s), bb, akk);
      aqk = MFMA32(*(const bf16x8*)(qp + 16 * s), bb, aqk);
    }
  }
  __syncthreads();
  {
    const int j = 32 * nj + r; const float gcj = gcs[j];
#pragma unroll
    for (int q = 0; q < 16; ++q) {
      const int i = 32 * mi + crow(q, hh);
      const float dec = i >= j ? expf(gcs[i] - gcj) : 0.f;
      Am[i * 64 + j] = i > j ? bts[i] * akk[q] * dec : 0.f;
      Cqk[i * 64 + j] = f2bf(aqk[q] * dec);
    }
  }
  {
    const float gl = gcs[63];
    for (int e = tid; e < 128 * 16; e += 256) {
      const int k = e >> 4, i4 = (e & 15) * 4;
      float v0 = bf2f(ks[(i4 + 0) * 136 + k]) * expf(gl - gcs[i4 + 0]);
      float v1 = bf2f(ks[(i4 + 1) * 136 + k]) * expf(gl - gcs[i4 + 1]);
      float v2 = bf2f(ks[(i4 + 2) * 136 + k]) * expf(gl - gcs[i4 + 2]);
      float v3 = bf2f(ks[(i4 + 3) * 136 + k]) * expf(gl - gcs[i4 + 3]);
      *(s16x4*)(CkdT + k * 64 + i4) = pack4(v0, v1, v2, v3);
    }
    if (tid == 0) Cgl[ci] = expf(gl);
  }
  __syncthreads();
  if (wv == 0) {
    float T[64];
    const float4* Am4 = (const float4*)Am;
    T[0] = (lane == 0) ? 1.f : 0.f;
    float4 an[8];
    an[0] = Am4[16];
    inv_all(T, an, Am4, lane, std::make_integer_sequence<int, 63>{});
#pragma unroll
    for (int i = 0; i < 64; ++i) Tb[i * 72 + lane] = f2bf(T[i]);
  }
  __syncthreads();
  {
#pragma unroll
    for (int mt = 0; mt < 2; ++mt) {
      f32x16 au = zero16(), aw = zero16();
#pragma unroll
      for (int s = 0; s < 4; ++s) {
        bf16x8 tf = *(const bf16x8*)(Tb + (32 * mt + r) * 72 + 16 * s + 8 * hh);
        bf16x8 vf = *(const bf16x8*)(vbT + (32 * wv + r) * 72 + 16 * s + 8 * hh);
        bf16x8 kf = *(const bf16x8*)(kgT + (32 * wv + r) * 72 + 16 * s + 8 * hh);
        au = MFMA32(tf, vf, au);
        aw = MFMA32(kf, tf, aw);
      }
#pragma unroll
      for (int gq = 0; gq < 4; ++gq) {
        *(s16x4*)(CuT + (32 * wv + r) * 64 + 32 * mt + 8 * gq + 4 * hh) = pack4(au[4 * gq], au[4 * gq + 1], au[4 * gq + 2], au[4 * gq + 3]);
        *(s16x4*)(Cw + (32 * mt + r) * 128 + 32 * wv + 8 * gq + 4 * hh) = pack4(aw[4 * gq], aw[4 * gq + 1], aw[4 * gq + 2], aw[4 * gq + 3]);
      }
    }
  }
  __syncthreads();
}

struct DnRegs { bf16x8 a1[8]; bf16x8 akd[4]; bf16x8 aqk[4]; s16x4 u[4]; float gl; };
DI void dn_load_a(const Params& p, DnRegs& R, int ci, int cb, int wv, int r, int hh) {
  unsigned char* C0 = p.ws + W_C0;
  const bf16_t* A1 = (const bf16_t*)(C0 + (wv < 2 ? C0_W : C0_QD)) + (size_t)ci * 8192 + (32 * (wv & 1) + r) * 128 + 8 * hh;
#pragma unroll
  for (int s = 0; s < 8; ++s) R.a1[s] = *(const bf16x8*)(A1 + 16 * s);
  if (wv < 2) {
    const bf16_t* U = (const bf16_t*)(C0 + C0_UT) + (size_t)ci * 8192 + (cb * 32 + r) * 64 + 32 * (wv & 1) + 4 * hh;
#pragma unroll
    for (int gq = 0; gq < 4; ++gq) R.u[gq] = *(const s16x4*)(U + 8 * gq);
  }
}
DI void dn_load_b(const Params& p, DnRegs& R, int ci, int cb, int wv, int r, int hh) {
  unsigned char* C0 = p.ws + W_C0;
  const bf16_t* Akd = (const bf16_t*)(C0 + C0_KDT) + (size_t)ci * 8192 + (32 * wv + r) * 64 + 8 * hh;
#pragma unroll
  for (int s = 0; s < 4; ++s) R.akd[s] = *(const bf16x8*)(Akd + 16 * s);
  if (wv >= 2) {
    const bf16_t* Aqk = (const bf16_t*)(C0 + C0_QK) + (size_t)ci * 4096 + (32 * (wv & 1) + r) * 64 + 8 * hh;
#pragma unroll
    for (int s = 0; s < 4; ++s) R.aqk[s] = *(const bf16x8*)(Aqk + 16 * s);
  }
  R.gl = ((const float*)(p.ws + W_DGL))[ci];
}
DI void dn_scan_item(const Params& p, int item, unsigned char* smem) {
  int tid_o = threadIdx.x; asm volatile("" : "+v"(tid_o)); const int tid = tid_o, lane = tid & 63, wv = tid >> 6, r = lane & 31, hh = lane >> 5;
  const int bh = item & 7, j_ = item >> 3; const int cb = j_ & 3, g = j_ >> 2, b = bh >> 2, h = bh & 3;
  const int n0 = 3 * g, n1 = n0 + 3;
  bf16_t* SbT = (bf16_t*)smem;
  bf16_t* vnT = SbT + 32 * 136;
  bf16_t* M = (bf16_t*)(p.ws + W_M);
  f32x16 S;
  DnRegs R;
  dn_load_a(p, R, bh * NCH + n0, cb, wv, r, hh);
  dn_load_b(p, R, bh * NCH + n0, cb, wv, r, hh);
  { const float* Sn = p.out + O_GLS + ((size_t)(bh * DN_NG + g) * 128) * 128;
#pragma unroll
    for (int q = 0; q < 16; ++q) S[q] = Sn[(32 * wv + crow(q, hh)) * 128 + cb * 32 + r]; }
  __syncthreads();
  for (int n = n0; n < n1; ++n) {
    const int cin = bh * NCH + (n + 1 < n1 ? n + 1 : n);
#pragma unroll
    for (int gq = 0; gq < 4; ++gq) *(s16x4*)(SbT + r * 136 + 32 * wv + 8 * gq + 4 * hh) = pack4(S[4 * gq], S[4 * gq + 1], S[4 * gq + 2], S[4 * gq + 3]);
    __syncthreads();
    f32x16 acc = zero16();
#pragma unroll
    for (int s = 0; s < 8; ++s) acc = MFMA32(R.a1[s], *(const bf16x8*)(SbT + r * 136 + 16 * s + 8 * hh), acc);
    if (wv < 2) {
#pragma unroll
      for (int gq = 0; gq < 4; ++gq) {
        float v0 = bf2f((bf16_t)R.u[gq][0]) - acc[4 * gq], v1 = bf2f((bf16_t)R.u[gq][1]) - acc[4 * gq + 1];
        float v2 = bf2f((bf16_t)R.u[gq][2]) - acc[4 * gq + 2], v3 = bf2f((bf16_t)R.u[gq][3]) - acc[4 * gq + 3];
        *(s16x4*)(vnT + r * 72 + 32 * (wv & 1) + 8 * gq + 4 * hh) = pack4(v0, v1, v2, v3);
      }
    }
    dn_load_a(p, R, cin, cb, wv, r, hh);
    __syncthreads();
    bf16x8 bv[4];
#pragma unroll
    for (int s = 0; s < 4; ++s) bv[s] = *(const bf16x8*)(vnT + r * 72 + 16 * s + 8 * hh);
#pragma unroll
    for (int q = 0; q < 16; ++q) S[q] *= R.gl;
#pragma unroll
    for (int s = 0; s < 4; ++s) S = MFMA32(R.akd[s], bv[s], S);
    if (wv >= 2) {
#pragma unroll
      for (int s = 0; s < 4; ++s) acc = MFMA32(R.aqk[s], bv[s], acc);
      const int tb = 64 * n - 48 + 32 * (wv & 1);
#pragma unroll
      for (int q = 0; q < 16; ++q) {
        const int t = tb + crow(q, hh);
        if (t >= 0) M[(size_t)(b * TP + t) * 1024 + 512 + h * 128 + cb * 32 + r] = f2bf(acc[q]);
      }
    }
    dn_load_b(p, R, cin, cb, wv, r, hh);
  }
  __syncthreads();
}

struct DnSt { u32x4 w0, w1, w2, w3, k0, k1, k2, k3, u0; float gl; };
DI void dn_l1_load(const Params& p, DnSt& R, int ci, int cb, int tid) {
  unsigned char* C0 = p.ws + W_C0;
  const u32x4* W4 = (const u32x4*)(C0 + C0_W + (size_t)ci * 16384) + tid;
  R.w0 = W4[0]; R.w1 = W4[256]; R.w2 = W4[512]; R.w3 = W4[768];
  const u32x4* K4 = (const u32x4*)(C0 + C0_KDT + (size_t)ci * 16384) + tid;
  R.k0 = K4[0]; R.k1 = K4[256]; R.k2 = K4[512]; R.k3 = K4[768];
  R.u0 = ((const u32x4*)(C0 + C0_UT + (size_t)ci * 16384 + (size_t)cb * 4096))[tid];
  R.gl = ((const float*)(p.ws + W_DGL))[ci];
}
DI void dn_l1_step(const DnSt& R, f32x16& S, unsigned char* smem, int tid, int lane, int wv, int r, int hh) {
  bf16_t* SbT = (bf16_t*)smem;
  bf16_t* vnT = SbT + 32 * 136;
  float4* part = (float4*)(smem + 16384);
  bf16_t* Wl = (bf16_t*)(smem + 24576);
  bf16_t* Kl = (bf16_t*)(smem + 41984);
  bf16_t* Ul = (bf16_t*)(smem + 60416);
  {
    const int i0 = tid, i1 = tid + 256, i2 = tid + 512, i3 = tid + 768;
    *(u32x4*)(Wl + (i0 >> 4) * 136 + (i0 & 15) * 8) = R.w0; *(u32x4*)(Wl + (i1 >> 4) * 136 + (i1 & 15) * 8) = R.w1;
    *(u32x4*)(Wl + (i2 >> 4) * 136 + (i2 & 15) * 8) = R.w2; *(u32x4*)(Wl + (i3 >> 4) * 136 + (i3 & 15) * 8) = R.w3;
    *(u32x4*)(Kl + (i0 >> 3) * 72 + (i0 & 7) * 8) = R.k0; *(u32x4*)(Kl + (i1 >> 3) * 72 + (i1 & 7) * 8) = R.k1;
    *(u32x4*)(Kl + (i2 >> 3) * 72 + (i2 & 7) * 8) = R.k2; *(u32x4*)(Kl + (i3 >> 3) * 72 + (i3 & 7) * 8) = R.k3;
    *(u32x4*)(Ul + (tid >> 3) * 72 + (tid & 7) * 8) = R.u0;
  }
#pragma unroll
  for (int gq = 0; gq < 4; ++gq) *(s16x4*)(SbT + r * 136 + 32 * wv + 8 * gq + 4 * hh) = pack4(S[4 * gq], S[4 * gq + 1], S[4 * gq + 2], S[4 * gq + 3]);
  __syncthreads();
  bf16x8 akd[4];
#pragma unroll
  for (int s = 0; s < 4; ++s) akd[s] = *(const bf16x8*)(Kl + (32 * wv + r) * 72 + 16 * s + 8 * hh);
  s16x4 u[4];
  if (wv < 2) {
#pragma unroll
    for (int gq = 0; gq < 4; ++gq) u[gq] = *(const s16x4*)(Ul + r * 72 + 32 * wv + 8 * gq + 4 * hh);
  }
  f32x16 acc = zero16();
#pragma unroll
  for (int s = 0; s < 4; ++s) acc = MFMA32(*(const bf16x8*)(Wl + (32 * (wv & 1) + r) * 136 + 64 * (wv >> 1) + 16 * s + 8 * hh), *(const bf16x8*)(SbT + r * 136 + 64 * (wv >> 1) + 16 * s + 8 * hh), acc);
  if (wv >= 2) {
#pragma unroll
    for (int gq = 0; gq < 4; ++gq) part[((wv & 1) * 4 + gq) * 64 + lane] = make_float4(acc[4 * gq], acc[4 * gq + 1], acc[4 * gq + 2], acc[4 * gq + 3]);
  }
  __syncthreads();
  if (wv < 2) {
#pragma unroll
    for (int gq = 0; gq < 4; ++gq) {
      const float4 pp = part[(wv * 4 + gq) * 64 + lane];
      float v0 = bf2f((bf16_t)u[gq][0]) - (acc[4 * gq] + pp.x), v1 = bf2f((bf16_t)u[gq][1]) - (acc[4 * gq + 1] + pp.y);
      float v2 = bf2f((bf16_t)u[gq][2]) - (acc[4 * gq + 2] + pp.z), v3 = bf2f((bf16_t)u[gq][3]) - (acc[4 * gq + 3] + pp.w);
      *(s16x4*)(vnT + r * 72 + 32 * wv + 8 * gq + 4 * hh) = pack4(v0, v1, v2, v3);
    }
  }
  __syncthreads();
#pragma unroll
  for (int q = 0; q < 16; ++q) S[q] *= R.gl;
#pragma unroll
  for (int s = 0; s < 4; ++s) S = MFMA32(akd[s], *(const bf16x8*)(vnT + r * 72 + 16 * s + 8 * hh), S);
}
DI void dn_l1_item(const Params& p, int item, unsigned char* smem) {
  int tid_o = threadIdx.x; asm volatile("" : "+v"(tid_o)); const int tid = tid_o, lane = tid & 63, wv = tid >> 6, r = lane & 31, hh = lane >> 5;
  const int bh = item & 7, cb = item >> 3;
  f32x16 S = zero16();
  DnSt R0, R1, R2;
  const int c0 = bh * NCH;
  dn_l1_load(p, R0, c0, cb, tid); dn_l1_load(p, R1, c0 + 1, cb, tid); dn_l1_load(p, R2, c0 + 2, cb, tid);
  __syncthreads();
  for (int it = 0; it < DN_NG; ++it) {
    const int n = 3 * it;
    { float* Sn = p.out + O_GLS + ((size_t)(bh * DN_NG + it) * 128) * 128;
#pragma unroll
      for (int q = 0; q < 16; ++q) Sn[(32 * wv + crow(q, hh)) * 128 + cb * 32 + r] = S[q]; }
    dn_l1_step(R0, S, smem, tid, lane, wv, r, hh); __builtin_amdgcn_sched_barrier(0); dn_l1_load(p, R0, c0 + (n + 3 < NCH ? n + 3 : NCH - 1), cb, tid); __builtin_amdgcn_sched_barrier(0);
    dn_l1_step(R1, S, smem, tid, lane, wv, r, hh); __builtin_amdgcn_sched_barrier(0); dn_l1_load(p, R1, c0 + (n + 4 < NCH ? n + 4 : NCH - 1), cb, tid); __builtin_amdgcn_sched_barrier(0);
    dn_l1_step(R2, S, smem, tid, lane, wv, r, hh); __builtin_amdgcn_sched_barrier(0); dn_l1_load(p, R2, c0 + (n + 5 < NCH ? n + 5 : NCH - 1), cb, tid); __builtin_amdgcn_sched_barrier(0);
  }
  float* So = p.out + O_DNP + (size_t)bh * 128 * 128;
#pragma unroll
  for (int q = 0; q < 16; ++q) So[(32 * wv + crow(q, hh)) * 128 + cb * 32 + r] = S[q];
  __syncthreads();
}

DI void gla_prep_item(const Params& p, int ci, unsigned char* smem) {
  int tid_o = threadIdx.x; asm volatile("" : "+v"(tid_o)); const int tid = tid_o, lane = tid & 63, wv = tid >> 6, r = lane & 31, hh = lane >> 5;
  const int n = ci % NCH, bh = ci / NCH, b = bh >> 2, h = bh & 3;
  float* gks = (float*)smem;
  float* bc = gks + 64 * 16;
  float* tot = bc + 64 * 128;
  bf16_t* qds = (bf16_t*)(tot + 128);
  bf16_t* kis = qds + 64 * 136;
  const bf16_t* P = (const bf16_t*)(p.ws + W_P);
  const float* sm1 = (const float*)(p.ws + W_SM1);
  unsigned char* C1 = p.ws + W_C1;
  bf16_t* Cqd = (bf16_t*)(C1 + C1_QD) + (size_t)ci * 8192;
  bf16_t* CkdT = (bf16_t*)(C1 + C1_KDT) + (size_t)ci * 8192;
  bf16_t* Cqk = (bf16_t*)(C1 + C1_QK) + (size_t)ci * 4096;
  float* Cgl = (float*)(p.ws + W_GGL) + (size_t)ci * 128;
  const int t0 = 64 * n - 48;
  __syncthreads();
  { float gq4[4];
#pragma unroll
    for (int u = 0; u < 4; ++u) { const int i = tid + 256 * u; const int t = t0 + (i >> 4); gq4[u] = sm1[(size_t)(b * TP + (t < 0 ? 0 : t)) * 16 + (i & 15)]; }
#pragma unroll
    for (int u = 0; u < 4; ++u) { const int i = tid + 256 * u; const int t = t0 + (i >> 4); gks[i] = t >= 0 ? gq4[u] : 0.f; } }
  __syncthreads();
  {
    const int k = tid & 127, half = tid >> 7;
    float wu[16];
    for (int rr = 0; rr < 16; ++rr) wu[rr] = p.w_gk_up[rr * 512 + h * 128 + k];
    const float bg = p.b_gk[h * 128 + k];
    float cum = 0.f;
    for (int ii = 0; ii < 32; ++ii) {
      const int i = 32 * half + ii, t = t0 + i;
      float la = 0.f;
      if (t >= 0) { float a = bg; for (int rr = 0; rr < 16; ++rr) a += gks[i * 16 + rr] * wu[rr]; la = logsigmoidf_(a) * (1.f / 16.f); }
      cum += la; bc[i * 128 + k] = cum;
    }
    if (half == 0) tot[k] = cum;
  }
  __syncthreads();
  { const int k = tid & 127, half = tid >> 7;
    if (half == 1) { const float tt = tot[k]; for (int ii = 32; ii < 64; ++ii) bc[ii * 128 + k] += tt; } }
  __syncthreads();
  {
    const int kp = (tid & 63) * 2, isub = tid >> 6;
    unsigned qw[16], kw[16];
#pragma unroll
    for (int m = 0; m < 16; ++m) {
      int t = t0 + isub + 4 * m; t = t < 0 ? 0 : t;
      const bf16_t* pp = P + (size_t)(b * TP + t) * NC + h * 128 + kp;
      qw[m] = *(const unsigned*)pp; kw[m] = *(const unsigned*)(pp + 512);
    }
#pragma unroll
    for (int m = 0; m < 16; ++m) {
      const int i = isub + 4 * m; const bool ok = (t0 + i) >= 0;
      const float2 bcv = *(const float2*)(bc + i * 128 + kp);
      const float q0 = ok ? __uint_as_float(qw[m] << 16) * 0.08838834764831845f : 0.f, q1 = ok ? __uint_as_float(qw[m] & 0xffff0000u) * 0.08838834764831845f : 0.f;
      const float k0 = ok ? __uint_as_float(kw[m] << 16) : 0.f, k1 = ok ? __uint_as_float(kw[m] & 0xffff0000u) : 0.f;
      const unsigned qd = (unsigned)f2bf(q0 * expf(bcv.x)) | ((unsigned)f2bf(q1 * expf(bcv.y)) << 16);
      *(unsigned*)(qds + i * 136 + kp) = qd; *(unsigned*)(Cqd + i * 128 + kp) = qd;
      *(unsigned*)(kis + i * 136 + kp) = (unsigned)f2bf(k0 * expf(-bcv.x)) | ((unsigned)f2bf(k1 * expf(-bcv.y)) << 16);
    }
  }
  __syncthreads();
  for (int e = tid; e < 128 * 16; e += 256) {
    const int k = e >> 4, i4 = (e & 15) * 4; const float eg = expf(bc[63 * 128 + k]);
    *(s16x4*)(CkdT + k * 64 + i4) = pack4(bf2f(kis[(i4 + 0) * 136 + k]) * eg, bf2f(kis[(i4 + 1) * 136 + k]) * eg, bf2f(kis[(i4 + 2) * 136 + k]) * eg, bf2f(kis[(i4 + 3) * 136 + k]) * eg);
  }
  if (tid < 128) Cgl[tid] = expf(bc[63 * 128 + tid]);
  {
    const int mi = wv >> 1, nj = wv & 1;
    f32x16 a = zero16();
#pragma unroll
    for (int s = 0; s < 8; ++s) a = MFMA32(*(const bf16x8*)(qds + (32 * mi + r) * 136 + 16 * s + 8 * hh), *(const bf16x8*)(kis + (32 * nj + r) * 136 + 16 * s + 8 * hh), a);
    const int j = 32 * nj + r;
#pragma unroll
    for (int q = 0; q < 16; ++q) { const int i = 32 * mi + crow(q, hh); Cqk[i * 64 + j] = f2bf(i >= j ? a[q] : 0.f); }
  }
  __syncthreads();
}

struct GlRegs { bf16x8 aq[8]; bf16x8 akd[4]; bf16x8 aqk[4]; bf16x8 bv[4]; float4 gl[4]; };
DI void gl_load_a(const Params& p, GlRegs& R, int bh, int n, int cb, int wv, int r, int hh) {
  const int ci = bh * NCH + n;
  unsigned char* C1 = p.ws + W_C1;
  if (wv < 2) {
    const bf16_t* A1 = (const bf16_t*)(C1 + C1_QD) + (size_t)ci * 8192 + (32 * wv + r) * 128 + 8 * hh;
#pragma unroll
    for (int s = 0; s < 8; ++s) R.aq[s] = *(const bf16x8*)(A1 + 16 * s);
    const bf16_t* Aqk = (const bf16_t*)(C1 + C1_QK) + (size_t)ci * 4096 + (32 * wv + r) * 64 + 8 * hh;
#pragma unroll
    for (int s = 0; s < 4; ++s) R.aqk[s] = *(const bf16x8*)(Aqk + 16 * s);
  }
}
DI void gl_load_b(const Params& p, GlRegs& R, int bh, int n, int cb, int wv, int r, int hh) {
  const int ci = bh * NCH + n; const int b = bh >> 2, h = bh & 3;
  unsigned char* C1 = p.ws + W_C1;
  const bf16_t* Akd = (const bf16_t*)(C1 + C1_KDT) + (size_t)ci * 8192 + (32 * wv + r) * 64 + 8 * hh;
#pragma unroll
  for (int s = 0; s < 4; ++s) R.akd[s] = *(const bf16x8*)(Akd + 16 * s);
  const bf16_t* V = (const bf16_t*)(p.ws + W_PT) + (size_t)(h * 256 + cb * 32 + r) * LDT + 128 + b * TP + 64 * n - 48 + 8 * hh;
#pragma unroll
  for (int s = 0; s < 4; ++s) R.bv[s] = *(const bf16x8*)(V + 16 * s);
  const float* G = (const float*)(p.ws + W_GGL) + (size_t)ci * 128 + 32 * wv + 4 * hh;
#pragma unroll
  for (int gq = 0; gq < 4; ++gq) R.gl[gq] = *(const float4*)(G + 8 * gq);
}
DI void gla_scan_item(const Params& p, int item, unsigned char* smem) {
  int tid_o = threadIdx.x; asm volatile("" : "+v"(tid_o)); const int tid = tid_o, lane = tid & 63, wv = tid >> 6, r = lane & 31, hh = lane >> 5;
  const int bh = item & 7, j_ = item >> 3; const int cb = j_ & 7, g = j_ >> 3, b = bh >> 2, h = bh & 3;
  const int n0 = 6 * g, n1 = (n0 + 6 < NCH) ? n0 + 6 : NCH;
  bf16_t* SbT = (bf16_t*)smem;
  bf16_t* M = (bf16_t*)(p.ws + W_M);
  f32x16 S;
  GlRegs R;
  gl_load_a(p, R, bh, n0, cb, wv, r, hh);
  gl_load_b(p, R, bh, n0, cb, wv, r, hh);
  { const float* Sn = (const float*)(p.ws + W_SNG) + ((size_t)(bh * GLA_NG + g) * 128) * 256;
#pragma unroll
    for (int q = 0; q < 16; ++q) S[q] = Sn[(32 * wv + crow(q, hh)) * 256 + cb * 32 + r]; }
  __syncthreads();
  for (int n = n0; n < n1; ++n) {
    const int nn = n + 1 < n1 ? n + 1 : n;
    bf16_t* Sb = SbT + (n & 1) * 32 * 136;
#pragma unroll
    for (int gq = 0; gq < 4; ++gq) *(s16x4*)(Sb + r * 136 + 32 * wv + 8 * gq + 4 * hh) = pack4(S[4 * gq], S[4 * gq + 1], S[4 * gq + 2], S[4 * gq + 3]);
    __syncthreads();
    if (wv < 2) {
      f32x16 acc = zero16();
#pragma unroll
      for (int s = 0; s < 8; ++s) acc = MFMA32(R.aq[s], *(const bf16x8*)(Sb + r * 136 + 16 * s + 8 * hh), acc);
#pragma unroll
      for (int s = 0; s < 4; ++s) acc = MFMA32(R.aqk[s], R.bv[s], acc);
      gl_load_a(p, R, bh, nn, cb, wv, r, hh);
      const int tb = 64 * n - 48 + 32 * wv;
#pragma unroll
      for (int q = 0; q < 16; ++q) {
        const int t = tb + crow(q, hh);
        if (t >= 0) M[(size_t)(b * TP + t) * 1024 + h * 256 + cb * 32 + r] = f2bf(acc[q]);
      }
    }
#pragma unroll
    for (int gq = 0; gq < 4; ++gq) { S[4 * gq] *= R.gl[gq].x; S[4 * gq + 1] *= R.gl[gq].y; S[4 * gq + 2] *= R.gl[gq].z; S[4 * gq + 3] *= R.gl[gq].w; }
#pragma unroll
    for (int s = 0; s < 4; ++s) S = MFMA32(R.akd[s], R.bv[s], S);
    gl_load_b(p, R, bh, nn, cb, wv, r, hh);
  }
  __syncthreads();
}

struct GlL1 { bf16x8 akd[4]; bf16x8 bv[4]; float4 gl[4]; };
DI void gl_l1_load(const Params& p, GlL1& R, int bh, int n, int cb, int wv, int r, int hh) {
  const int ci = bh * NCH + n; const int b = bh >> 2, h = bh & 3;
  unsigned char* C1 = p.ws + W_C1;
  const bf16_t* Akd = (const bf16_t*)(C1 + C1_KDT) + (size_t)ci * 8192 + (32 * wv + r) * 64 + 8 * hh;
#pragma unroll
  for (int s = 0; s < 4; ++s) R.akd[s] = *(const bf16x8*)(Akd + 16 * s);
  const bf16_t* V = (const bf16_t*)(p.ws + W_PT) + (size_t)(h * 256 + cb * 32 + r) * LDT + 128 + b * TP + 64 * n - 48 + 8 * hh;
#pragma unroll
  for (int s = 0; s < 4; ++s) R.bv[s] = *(const bf16x8*)(V + 16 * s);
  const float* G = (const float*)(p.ws + W_GGL) + (size_t)ci * 128 + 32 * wv + 4 * hh;
#pragma unroll
  for (int gq = 0; gq < 4; ++gq) R.gl[gq] = *(const float4*)(G + 8 * gq);
}
DI void gl_l1_step(const GlL1& R, f32x16& S) {
#pragma unroll
  for (int gq = 0; gq < 4; ++gq) { S[4 * gq] *= R.gl[gq].x; S[4 * gq + 1] *= R.gl[gq].y; S[4 * gq + 2] *= R.gl[gq].z; S[4 * gq + 3] *= R.gl[gq].w; }
#pragma unroll
  for (int s = 0; s < 4; ++s) S = MFMA32(R.akd[s], R.bv[s], S);
}
template <int PROBE>
DI void gla_l1_item(const Params& p, int item) {
  int tid_o = threadIdx.x; asm volatile("" : "+v"(tid_o)); const int tid = tid_o, lane = tid & 63, wv = tid >> 6, r = lane & 31, hh = lane >> 5;
  const int bh = item & 7, cb = item >> 3;
  f32x16 S = zero16();
  GlL1 R0, R1, R2;
  gl_l1_load(p, R0, bh, 0, cb, wv, r, hh); gl_l1_load(p, R1, bh, 1, cb, wv, r, hh); gl_l1_load(p, R2, bh, 2, cb, wv, r, hh);
  for (int it = 0; it < 43; ++it) {
    const int n = 3 * it;
    if (PROBE == 0 && (it & 1) == 0) { float* Sn = (float*)(p.ws + W_SNG) + ((size_t)(bh * GLA_NG + (it >> 1)) * 128) * 256;
#pragma unroll
      for (int q = 0; q < 16; ++q) Sn[(32 * wv + crow(q, hh)) * 256 + cb * 32 + r] = S[q]; }
    gl_l1_step(R0, S); __builtin_amdgcn_sched_barrier(0); if (PROBE != 1) gl_l1_load(p, R0, bh, (n + 3 < NCH ? n + 3 : NCH - 1), cb, wv, r, hh); __builtin_amdgcn_sched_barrier(0);
    gl_l1_step(R1, S); __builtin_amdgcn_sched_barrier(0); if (PROBE != 1) gl_l1_load(p, R1, bh, (n + 4 < NCH ? n + 4 : NCH - 1), cb, wv, r, hh); __builtin_amdgcn_sched_barrier(0);
    gl_l1_step(R2, S); __builtin_amdgcn_sched_barrier(0); if (PROBE != 1) gl_l1_load(p, R2, bh, (n + 5 < NCH ? n + 5 : NCH - 1), cb, wv, r, hh); __builtin_amdgcn_sched_barrier(0);
  }
  float* So = PROBE ? (float*)(p.ws + W_SNG) + (size_t)8 * GLA_NG * 128 * 256 + (size_t)bh * 128 * 256 : p.out + O_GLP + (size_t)bh * 128 * 256;
#pragma unroll
  for (int q = 0; q < 16; ++q) So[(32 * wv + crow(q, hh)) * 256 + cb * 32 + r] = S[q];
}

DI void gla_grp_item(const Params& p, int item) {
  int tid_o = threadIdx.x; asm volatile("" : "+v"(tid_o)); const int tid = tid_o, lane = tid & 63, wv = tid >> 6, r = lane & 31, hh = lane >> 5;
  const int bh = item & 7, j_ = item >> 3; const int cb = j_ & 7, g = j_ >> 3;
  const int n0 = 6 * g, n1 = (n0 + 6 < NCH) ? n0 + 6 : NCH;
  f32x16 S = zero16();
  float4 ap[4];
#pragma unroll
  for (int gq = 0; gq < 4; ++gq) ap[gq] = make_float4(1.f, 1.f, 1.f, 1.f);
  GlL1 R0, R1, R2;
  gl_l1_load(p, R0, bh, n0, cb, wv, r, hh); gl_l1_load(p, R1, bh, n0 + 1, cb, wv, r, hh); gl_l1_load(p, R2, bh, n0 + 2, cb, wv, r, hh);
  for (int n = n0; n < n1; n += 3) {
    const int na = n + 3 < n1 ? n + 3 : n1 - 1, nb = n + 4 < n1 ? n + 4 : n1 - 1, nc = n + 5 < n1 ? n + 5 : n1 - 1;
#pragma unroll
    for (int gq = 0; gq < 4; ++gq) { ap[gq].x *= R0.gl[gq].x; ap[gq].y *= R0.gl[gq].y; ap[gq].z *= R0.gl[gq].z; ap[gq].w *= R0.gl[gq].w; }
    gl_l1_step(R0, S); __builtin_amdgcn_sched_barrier(0); gl_l1_load(p, R0, bh, na, cb, wv, r, hh); __builtin_amdgcn_sched_barrier(0);
#pragma unroll
    for (int gq = 0; gq < 4; ++gq) { ap[gq].x *= R1.gl[gq].x; ap[gq].y *= R1.gl[gq].y; ap[gq].z *= R1.gl[gq].z; ap[gq].w *= R1.gl[gq].w; }
    gl_l1_step(R1, S); __builtin_amdgcn_sched_barrier(0); gl_l1_load(p, R1, bh, nb, cb, wv, r, hh); __builtin_amdgcn_sched_barrier(0);
#pragma unroll
    for (int gq = 0; gq < 4; ++gq) { ap[gq].x *= R2.gl[gq].x; ap[gq].y *= R2.gl[gq].y; ap[gq].z *= R2.gl[gq].z; ap[gq].w *= R2.gl[gq].w; }
    gl_l1_step(R2, S); __builtin_amdgcn_sched_barrier(0); gl_l1_load(p, R2, bh, nc, cb, wv, r, hh); __builtin_amdgcn_sched_barrier(0);
  }
  float* Dg = (float*)(p.ws + W_SNG) + ((size_t)(bh * GLA_NG + g) * 128) * 256;
#pragma unroll
  for (int q = 0; q < 16; ++q) Dg[(32 * wv + crow(q, hh)) * 256 + cb * 32 + r] = S[q];
  if (cb == 0 && r == 0) {
    float* Ag = (float*)(p.ws + W_AG) + (size_t)(bh * GLA_NG + g) * 128 + 32 * wv + 4 * hh;
#pragma unroll
    for (int gq = 0; gq < 4; ++gq) *(float4*)(Ag + 8 * gq) = ap[gq];
  }
}
DI void gla_gscan(const Params& p, int idx) {
  const int bh = idx >> 13, k = (idx >> 6) & 127, v4 = idx & 63;
  float* base = (float*)(p.ws + W_SNG) + ((size_t)(bh * GLA_NG) * 128 + k) * 256 + v4 * 4;
  const float* ab = (const float*)(p.ws + W_AG) + (size_t)(bh * GLA_NG) * 128 + k;
  float4 d[GLA_NG]; float a[GLA_NG];
#pragma unroll
  for (int g = 0; g < GLA_NG; ++g) { d[g] = nt_load4(base + (size_t)g * 128 * 256); a[g] = ab[g * 128]; }
  float4 S = make_float4(0.f, 0.f, 0.f, 0.f);
#pragma unroll
  for (int g = 0; g < GLA_NG; ++g) {
    *(float4*)(base + (size_t)g * 128 * 256) = S;
    S.x = a[g] * S.x + d[g].x; S.y = a[g] * S.y + d[g].y; S.z = a[g] * S.z + d[g].z; S.w = a[g] * S.w + d[g].w;
  }
  *(float4*)(p.out + O_GLP + ((size_t)bh * 128 + k) * 256 + v4 * 4) = S;
}

DI void gate0_phase(const Params& p) {
  const int lane = threadIdx.x & 63, wv = threadIdx.x >> 6;
  const bf16_t* P = (const bf16_t*)(p.ws + W_P);
  bf16_t* M = (bf16_t*)(p.ws + W_M);
  float gn[8];
#pragma unroll
  for (int e = 0; e < 8; ++e) gn[e] = p.onorm_b[(lane * 8 + e) & 127];
  const int stride = gridDim.x * 4;
  int r = blockIdx.x * 4 + wv;
  bf16x8 ovn, zvn;
  if (r < NROWS) { ovn = *(const bf16x8*)(M + (size_t)r * 1024 + 512 + lane * 8); zvn = __builtin_nontemporal_load((const bf16x8*)(P + (size_t)r * NA + 2816 + lane * 8)); }
  for (; r < NROWS; r += stride) {
    const bf16x8 ov = ovn, zv = zvn;
    const int rn = r + stride;
    if (rn < NROWS) { ovn = *(const bf16x8*)(M + (size_t)rn * 1024 + 512 + lane * 8); zvn = __builtin_nontemporal_load((const bf16x8*)(P + (size_t)rn * NA + 2816 + lane * 8)); }
    float o[8]; float ss = 0.f;
#pragma unroll
    for (int e = 0; e < 8; ++e) { o[e] = bf2f((bf16_t)ov[e]); ss += o[e] * o[e]; }
    for (int m = 1; m < 16; m <<= 1) ss += __shfl_xor(ss, m);
    const float rs = rsqrtf(ss * (1.f / 128.f) + EPS);
    bf16x8 res;
#pragma unroll
    for (int e = 0; e < 8; ++e) res[e] = (short)f2bf(o[e] * rs * gn[e] * siluf_(bf2f((bf16_t)zv[e])));
    *(bf16x8*)(M + (size_t)r * 1024 + 512 + lane * 8) = res;
  }
}
DI void gate1_phase(const Params& p) {
  const int lane = threadIdx.x & 63, wv = threadIdx.x >> 6;
  const bf16_t* P = (const bf16_t*)(p.ws + W_P);
  bf16_t* M = (bf16_t*)(p.ws + W_M);
  float gn[16];
#pragma unroll
  for (int e = 0; e < 16; ++e) gn[e] = p.onorm_c[(lane * 16 + e) & 255];
  const int stride = gridDim.x * 4;
  int r = blockIdx.x * 4 + wv;
  bf16x8 o0n, o1n, z0n, z1n;
  if (r < NROWS) { o0n = *(const bf16x8*)(M + (size_t)r * 1024 + lane * 16); o1n = *(const bf16x8*)(M + (size_t)r * 1024 + lane * 16 + 8);
                   z0n = __builtin_nontemporal_load((const bf16x8*)(P + (size_t)r * NC + 2048 + lane * 16)); z1n = __builtin_nontemporal_load((const bf16x8*)(P + (size_t)r * NC + 2048 + lane * 16 + 8)); }
  for (; r < NROWS; r += stride) {
    const bf16x8 o0 = o0n, o1 = o1n, z0 = z0n, z1 = z1n;
    const int rn = r + stride;
    if (rn < NROWS) { o0n = *(const bf16x8*)(M + (size_t)rn * 1024 + lane * 16); o1n = *(const bf16x8*)(M + (size_t)rn * 1024 + lane * 16 + 8);
                      z0n = __builtin_nontemporal_load((const bf16x8*)(P + (size_t)rn * NC + 2048 + lane * 16)); z1n = __builtin_nontemporal_load((const bf16x8*)(P + (size_t)rn * NC + 2048 + lane * 16 + 8)); }
    float o[16]; float ss = 0.f;
#pragma unroll
    for (int e = 0; e < 8; ++e) { o[e] = bf2f((bf16_t)o0[e]); o[8 + e] = bf2f((bf16_t)o1[e]); ss += o[e] * o[e] + o[8 + e] * o[8 + e]; }
    for (int m = 1; m < 16; m <<= 1) ss += __shfl_xor(ss, m);
    const float rs = rsqrtf(ss * (1.f / 256.f) + EPS);
    bf16x8 r0, r1;
#pragma unroll
    for (int e = 0; e < 8; ++e) { r0[e] = (short)f2bf(o[e] * rs * gn[e] * siluf_(bf2f((bf16_t)z0[e]))); r1[e] = (short)f2bf(o[8 + e] * rs * gn[8 + e] * siluf_(bf2f((bf16_t)z1[e]))); }
    *(bf16x8*)(M + (size_t)r * 1024 + lane * 16) = r0; *(bf16x8*)(M + (size_t)r * 1024 + lane * 16 + 8) = r1;
  }
}

__global__ void __launch_bounds__(256, 2) fwd_megakernel(Params p) {
  cg::grid_group grid = cg::this_grid();
  __shared__ __attribute__((aligned(16))) unsigned char smem[SMEM_BYTES];
  const int tid = threadIdx.x;
  const int G = gridDim.x, B = blockIdx.x;
  __shared__ uint4 xb_words;
  if (tid == 0) xb_words = make_uint4(0u, 0u, 0u, 0u);
  __syncthreads();
  const XcdBarrier xb = xcd_barrier_post((unsigned*)(p.ws + W_BAR), (volatile LAS unsigned*)&xb_words);
  bf16_t* WtA = (bf16_t*)(p.ws + W_WTA); bf16_t* WoA = (bf16_t*)(p.ws + W_WOA);
  bf16_t* WtC = (bf16_t*)(p.ws + W_WTC); bf16_t* WoC = (bf16_t*)(p.ws + W_WOC);
  bf16_t* P = (bf16_t*)(p.ws + W_P); bf16_t* M = (bf16_t*)(p.ws + W_M); bf16_t* Pt = (bf16_t*)(p.ws + W_PT);
  bf16_t* H0 = (bf16_t*)(p.ws + W_C0); bf16_t* H1 = (bf16_t*)(p.ws + W_C1);

  REP(0) {
  for (int t = B; t < 1088; t += G) {
    if (t < 832) wt_tile(p.w_in_ab, LDA_IN, WtA, t, (float*)smem);
    else wt_tile(p.w_out_ab, 1024, WoA, t - 832, (float*)smem);
  }
  for (int i = B * 256 + tid; i < 128 * 128; i += G * 256) Pt[(size_t)(i >> 7) * LDT + (i & 127)] = 0;
  norm_phase<8, 0>(p, p.norm_ab, p.w_in_ab, LDA_IN, NA, H0, (float*)(p.ws + W_SM0), (float*)smem);
  }
  if (p.coop_flag) grid.sync();
  xcd_barrier(xb);
  REP(1) { gemm_phase<0>(p, H0, WtA, NA / 128, (bf16_t*)smem, B, G);
  xcd_barrier(xb); }
  REP(2) { for (int it = B; it < NCI; it += G) dn_prep_item(p, it, smem); if (DUP == 2) xcd_barrier(xb); }
  for (int i = B * 256 + tid; i < 2 * 128 * 128; i += G * 256) {
    const int b = i >> 14, rr = (i >> 7) & 127, c = i & 127; const size_t row = (size_t)(b * TP + TP - 128 + rr);
    p.out[O_SKP + i] = bf2f(P[row * NA + 512 + c]); p.out[O_SVP + i] = bf2f(P[row * NA + 640 + c]);
  }
  for (int i = B * 256 + tid; i < 2 * 3 * 1536; i += G * 256) {
    const int b = i / 4608, rr = (i / 1536) % 3, c = i % 1536;
    p.out[O_CVP + i] = bf2f(P[(size_t)(b * TP + TP - 3 + rr) * NA + 1280 + c]);
  }
  xcd_barrier(xb);
  if (DUP == 13) { if (B < 32) dn_l1_item(p, B, smem); xcd_barrier(xb); }
  if (DUP == 14) { if (B >= 32) for (int it = B - 32; it < 2 * 65 * 8; it += G - 32) swa_prompt_item(p, it); xcd_barrier(xb); }
  REP(15) {
  if (B < 32) dn_l1_item(p, B, smem);
  else {
    const int W = G - 32, wb = B - 32;
    for (int it = wb; it < 2 * 65 * 8; it += W) swa_prompt_item(p, it);
    for (int it = W - 1 - wb; it < 128; it += W) swa_sample_item(p, it, (float*)smem);
    for (int it = (wb + 200) % W; it < 512; it += W) dn_sample_item(p, it, (float*)smem);
    for (int t = wb; t < 1024; t += W) {
      if (t < 768) wt_tile(p.w_in_c, LDC_IN, WtC, t, (float*)smem);
      else wt_tile(p.w_out_c, 1024, WoC, t - 768, (float*)smem);
    }
  }
  xcd_barrier(xb);
  }
  REP(3) { for (int it = B; it < 32 * DN_NG; it += G) dn_scan_item(p, it, smem);
  xcd_barrier(xb); }
  gate0_phase(p);
  xcd_barrier(xb);
  REP(5) { gemm_phase<1>(p, M, WoA, 8, (bf16_t*)smem, B, G);
  xcd_barrier(xb); }
  for (int i = B * 256 + tid; i < 1024 * 128; i += G * 256) Pt[(size_t)(i >> 7) * LDT + (i & 127)] = 0;
  REP(6) {
  norm_phase<16, 1>(p, p.norm_c, p.w_in_c, LDC_IN, NC, H1, (float*)(p.ws + W_SM1), (float*)smem);
  }
  xcd_barrier(xb);
  gemm_phase<2>(p, H1, WtC, NC / 128, (bf16_t*)smem, B, G);
  xcd_barrier(xb);
  REP(8) { for (int it = B; it < NCI; it += G) gla_prep_item(p, it, smem); if (DUP == 8) xcd_barrier(xb); }
  xcd_barrier(xb);
  for (int it = B; it < 64 * GLA_NG; it += G) gla_grp_item(p, it);
  for (int it = G - 1 - B; it < 1024; it += G) gla_sample_item(p, it, (float*)smem);
  xcd_barrier(xb);
  for (int idx = B * 256 + tid; idx < 8 * 128 * 64; idx += G * 256) gla_gscan(p, idx);
  xcd_barrier(xb);
  REP(9) { for (int it = B; it < 64 * GLA_NG; it += G) gla_scan_item(p, it, smem);
  xcd_barrier(xb); }
  gate1_phase(p);
  xcd_barrier(xb);
  gemm_phase<3>(p, M, WoC, 8, (bf16_t*)smem, B, G);
  xcd_barrier(xb);
  {
    const int lane = tid & 63, wv = tid >> 6;
    float4 gv[4];
#pragma unroll
    for (int i = 0; i < 4; ++i) gv[i] = *(const float4*)(p.final_norm + 4 * lane + 256 * i);
    const int stride = G * 4;
    int r = B * 4 + wv;
    float4 xn[4];
    if (r < NROWS) { const float* yr = yrow(p, r);
#pragma unroll
      for (int i = 0; i < 4; ++i) xn[i] = nt_load4(yr + 4 * lane + 256 * i); }
    for (; r < NROWS; r += stride) {
      float4 xc[4];
#pragma unroll
      for (int i = 0; i < 4; ++i) xc[i] = xn[i];
      const int rn = r + stride;
      if (rn < NROWS) { const float* yn = yrow(p, rn);
#pragma unroll
        for (int i = 0; i < 4; ++i) xn[i] = nt_load4(yn + 4 * lane + 256 * i); }
      if (r < NPR) { const int t = r >= TP ? r - TP : r; if (t < 16) continue; }
      float* yr = yrow(p, r);
      float ss = 0.f;
#pragma unroll
      for (int i = 0; i < 4; ++i) ss += xc[i].x * xc[i].x + xc[i].y * xc[i].y + xc[i].z * xc[i].z + xc[i].w * xc[i].w;
      ss = wsum(ss);
      const float rstd = rsqrtf(ss * (1.f / 1024.f) + EPS);
#pragma unroll
      for (int i = 0; i < 4; ++i) nt_store4(yr + 4 * lane + 256 * i, make_float4(xc[i].x * rstd * gv[i].x, xc[i].y * rstd * gv[i].y, xc[i].z * rstd * gv[i].z, xc[i].w * rstd * gv[i].w));
    }
  }
}

extern "C" void kernel_launch(void* const* d_in, const int* in_sizes, int n_in, void* d_out,
                              int out_size, void* d_ws, size_t ws_size, hipStream_t stream) {
  static int grid_blocks = 0;
  if (!grid_blocks) {
    int dev = 0, cus = 0, per_cu = 0;
    (void)hipGetDevice(&dev);
    (void)hipDeviceGetAttribute(&cus, hipDeviceAttributeMultiprocessorCount, dev);
    (void)hipOccupancyMaxActiveBlocksPerMultiprocessor(&per_cu, fwd_megakernel, 256, 0);
    if (per_cu > 2) per_cu = 2;
    if (per_cu < 1) per_cu = 1;
    grid_blocks = cus * per_cu;
  }
  Params p{};
  const float* const* in = (const float* const*)d_in;
  p.x_prompt = in[0]; p.x_sample = in[1]; p.cache_k = in[2]; p.cache_v = in[3];
  p.st_conv = in[4]; p.st_dn = in[5]; p.st_gla = in[6]; p.meta = in[7];
  p.norm_ab = in[8]; p.w_in_ab = in[9]; p.sink = in[10]; p.conv_b = in[11];
  p.a_log = in[12]; p.dt_bias = in[13]; p.onorm_b = in[14]; p.w_out_ab = in[15];
  p.norm_c = in[16]; p.w_in_c = in[17]; p.w_gk_up = in[18]; p.b_gk = in[19];
  p.onorm_c = in[20]; p.w_out_c = in[21]; p.final_norm = in[22];
  p.out = (float*)d_out; p.ws = (unsigned char*)d_ws;
  (void)hipMemsetAsync((unsigned char*)d_ws + W_BAR, 0, XCD_BAR_WORDS * 4, stream);
  void* args[] = {&p};
  hipError_t e = hipLaunchCooperativeKernel((void*)fwd_megakernel, dim3(grid_blocks), dim3(256), args, 0, stream);
  if (e != hipSuccess) fprintf(stderr, "cooperative launch failed: %s (grid %d)\n", hipGetErrorString(e), grid_blocks);
}
```
